# Optimizing an MI355X kernel written in HIP

```python
import jax, jax.numpy as jnp
from jax import lax
import numpy as np

D_MODEL = 1024
BATCH = 4
SEQ = 8192
DEPTH = 4
DEC_BATCH = 16
DEC_SEQ = 64
PAST_LEN = 2048

CHUNK = 64
N_MIXERS = 2
N_POOL = (DEPTH + 1) // 2
N_HGRN = DEPTH // 2
POOL_WINDOWS = (2, 4, 8, 16)
POOL_GROUPS = len(POOL_WINDOWS)
POOL_GW = D_MODEL // POOL_GROUPS
POOL_CACHE = min(max(POOL_WINDOWS) - 1, PAST_LEN)
HG_HEAD_DIM = 128
HG_HEADS = D_MODEL // HG_HEAD_DIM
D_FF = 2816
CONV_W = 3
EPS = 1e-6

kernel_name = 'pool_hgrn2_convffn_stream_step'

F32 = jnp.float32


def rmsnorm(x, g):
    xf = x.astype(F32)
    y = xf * lax.rsqrt(jnp.mean(xf * xf, axis=-1, keepdims=True) + EPS)
    return (y * g.astype(F32)).astype(x.dtype)


def pool_mix(h, hist, pos0, w, scale):
    L = h.shape[1]
    P = hist.shape[1]
    ext = jnp.concatenate([hist.astype(h.dtype), h], axis=1)
    c = jnp.pad(jnp.cumsum(ext.astype(F32), axis=1), ((0, 0), (1, 0), (0, 0)))
    end = jnp.arange(L) + P + 1
    pos = jnp.arange(L) + pos0
    outs = []
    for g, win in enumerate(POOL_WINDOWS):
        sl = slice(g * POOL_GW, (g + 1) * POOL_GW)
        cg = c[..., sl]
        lo = jnp.maximum(end - win, 0)
        wsum = cg[:, P + 1:] - jnp.take(cg, lo, axis=1)
        div = jnp.minimum(win, pos + 1).astype(F32)
        d = wsum / div[None, :, None] - h[..., sl].astype(F32)
        outs.append(jnp.einsum('bld,de->ble', d.astype(h.dtype), w[g]))
    y = jnp.concatenate(outs, axis=-1) * scale
    return y, ext[:, -POOL_CACHE:]


def hgrn_chunk(S, inp):
    q, k, v, g = inp
    C = q.shape[2]
    b = jnp.cumsum(g, axis=2)
    causal = jnp.tril(jnp.ones((C, C), dtype=bool))
    diff = b[:, :, :, None, :] - b[:, :, None, :, :]
    decay = jnp.exp(jnp.where(causal[None, None, :, :, None], diff, -jnp.inf))
    A = jnp.einsum('bhtk,bhsk,bhtsk->bhts', q, k, decay)
    o = jnp.einsum('bhtk,bhkv->bhtv', q * jnp.exp(b), S) + jnp.einsum('bhts,bhsv->bhtv', A, v)
    bC = b[:, :, -1:, :]
    S_new = jnp.exp(bC[:, :, 0, :])[..., None] * S + jnp.einsum('bhsk,bhsv->bhkv', k * jnp.exp(bC - b), v)
    return S_new, o


def hgrn_mix(h, S0, w_in, lb, gn, w_out):
    B, L, _ = h.shape
    proj = jnp.einsum('bld,de->ble', h, w_in).astype(F32)
    zq, zf, zi, zg = jnp.split(proj, 4, axis=-1)
    lbf = lb.astype(F32)
    q = jax.nn.silu(zq)
    log_f = jnp.logaddexp(jnp.log(lbf), jnp.log1p(-lbf) + jax.nn.log_sigmoid(zf))
    k = (1.0 - lbf) * jax.nn.sigmoid(-zf)
    C = CHUNK if L % CHUNK == 0 else L
    nc = L // C

    def to_chunks(a):
        return a.reshape(B, nc, C, HG_HEADS, HG_HEAD_DIM).transpose(1, 0, 3, 2, 4)

    S_fin, o = lax.scan(hgrn_chunk, S0.astype(F32), (to_chunks(q), to_chunks(k), to_chunks(zi), to_chunks(log_f)))
    o = o.transpose(1, 0, 3, 2, 4).reshape(B, L, HG_HEADS, HG_HEAD_DIM)
    o = o * lax.rsqrt(jnp.mean(o * o, axis=-1, keepdims=True) + EPS) * gn.astype(F32).reshape(HG_HEADS, HG_HEAD_DIM)
    o = o.reshape(B, L, D_MODEL) * jax.nn.silu(zg)
    y = jnp.einsum('bld,de->ble', o.astype(h.dtype), w_out)
    return y, S_fin


def conv_ffn(h, hist, w_up, cw, cb, w_down):
    L = h.shape[1]
    up = jnp.einsum('bld,df->blf', h, w_up)
    gate_pre, val = jnp.split(up, 2, axis=-1)
    ext = jnp.concatenate([hist.astype(up.dtype), gate_pre], axis=1)
    conv = cb
    for j in range(CONV_W):
        conv = conv + cw[j] * ext[:, j:j + L]
    hid = jax.nn.silu(conv.astype(F32)) * val.astype(F32)
    y = jnp.einsum('blf,fd->bld', hid.astype(h.dtype), w_down)
    return y, ext[:, -(CONV_W - 1):]


def trunk(x, pool_hist, hgrn_S, conv_hist, pos0, lb_all, norm_mix_g, pool_w, pool_scale, hgrn_w_in,
          hgrn_norm_g, hgrn_w_out, norm_ffn_g, ffn_w_up, ffn_conv_w, ffn_conv_b, ffn_w_down, norm_out_g):
    new_pool, new_hgrn, new_conv = [], [], []
    for i in range(DEPTH):
        hn = rmsnorm(x, norm_mix_g[i])
        j = i // N_MIXERS
        if i % N_MIXERS == 0:
            y, st = pool_mix(hn, pool_hist[j], pos0, pool_w[j], pool_scale[j])
            new_pool.append(st)
        else:
            y, st = hgrn_mix(hn, hgrn_S[j], hgrn_w_in[j], lb_all[i], hgrn_norm_g[j], hgrn_w_out[j])
            new_hgrn.append(st)
        x = x + y.astype(x.dtype)
        hn = rmsnorm(x, norm_ffn_g[i])
        y, cs = conv_ffn(hn, conv_hist[i], ffn_w_up[i], ffn_conv_w[i], ffn_conv_b[i], ffn_w_down[i])
        new_conv.append(cs)
        x = x + y.astype(x.dtype)
    x = rmsnorm(x, norm_out_g)
    return x, jnp.stack(new_pool), jnp.stack(new_hgrn), jnp.stack(new_conv)


def setup_inputs(seed: int = 0) -> dict:
    key = jax.random.key(seed)
    ks = jax.random.split(key, 18)
    n = jax.random.normal
    D, F = D_MODEL, D_FF
    return {
        'x_prompt': n(ks[0], (BATCH, SEQ, D), F32),
        'x_sample': n(ks[1], (DEC_BATCH, DEC_SEQ, D), F32),
        'state_pool': n(ks[2], (N_POOL, DEC_BATCH, POOL_CACHE, D), F32),
        'state_hgrn': 0.5 * n(ks[3], (N_HGRN, DEC_BATCH, HG_HEADS, HG_HEAD_DIM, HG_HEAD_DIM), F32),
        'state_ffn_conv': n(ks[4], (DEPTH, DEC_BATCH, CONV_W - 1, F), F32),
        'norm_mix_g': 1.0 + 0.02 * n(ks[5], (DEPTH, D), F32),
        'pool_w': n(ks[6], (N_POOL, POOL_GROUPS, POOL_GW, POOL_GW), F32) * POOL_GW ** -0.5,
        'pool_scale': 1.0 + 0.1 * n(ks[7], (N_POOL, D), F32),
        'hgrn_w_in': n(ks[8], (N_HGRN, D, 4 * D), F32) * D ** -0.5,
        'hgrn_lb_logits': 0.1 * n(ks[9], (DEPTH, D), F32),
        'hgrn_norm_g': 1.0 + 0.02 * n(ks[10], (N_HGRN, D), F32),
        'hgrn_w_out': n(ks[11], (N_HGRN, D, D), F32) * D ** -0.5,
        'norm_ffn_g': 1.0 + 0.02 * n(ks[12], (DEPTH, D), F32),
        'ffn_w_up': n(ks[13], (DEPTH, D, 2 * F), F32) * D ** -0.5,
        'ffn_conv_w': n(ks[14], (DEPTH, CONV_W, F), F32) * CONV_W ** -0.5,
        'ffn_conv_b': 0.01 * n(ks[15], (DEPTH, F), F32),
        'ffn_w_down': n(ks[16], (DEPTH, F, D), F32) * F ** -0.5,
        'norm_out_g': 1.0 + 0.02 * n(ks[17], (D,), F32),
    }


def reference(x_prompt, x_sample, state_pool, state_hgrn, state_ffn_conv, norm_mix_g, pool_w, pool_scale,
              hgrn_w_in, hgrn_lb_logits, hgrn_norm_g, hgrn_w_out, norm_ffn_g, ffn_w_up, ffn_conv_w,
              ffn_conv_b, ffn_w_down, norm_out_g):
    sm = jax.nn.softmax(hgrn_lb_logits.astype(F32), axis=0)
    lb_all = jnp.cumsum(sm, axis=0) - sm[0]
    weights = (norm_mix_g, pool_w, pool_scale, hgrn_w_in, hgrn_norm_g, hgrn_w_out, norm_ffn_g,
               ffn_w_up, ffn_conv_w, ffn_conv_b, ffn_w_down, norm_out_g)

    Bp = x_prompt.shape[0]
    p_pool = [jnp.zeros((Bp, 0, D_MODEL), x_prompt.dtype) for _ in range(N_POOL)]
    p_hgrn = [jnp.zeros((Bp, HG_HEADS, HG_HEAD_DIM, HG_HEAD_DIM), F32) for _ in range(N_HGRN)]
    p_conv = [jnp.zeros((Bp, CONV_W - 1, D_FF), x_prompt.dtype) for _ in range(DEPTH)]
    y_prompt, pool_p, hgrn_p, conv_p = trunk(x_prompt, p_pool, p_hgrn, p_conv, 0, lb_all, *weights)

    s_pool = [state_pool[j] for j in range(N_POOL)]
    s_hgrn = [state_hgrn[j] for j in range(N_HGRN)]
    s_conv = [state_ffn_conv[i] for i in range(DEPTH)]
    y_sample, pool_s, hgrn_s, conv_s = trunk(x_sample, s_pool, s_hgrn, s_conv, PAST_LEN, lb_all, *weights)

    return (y_prompt, y_sample, pool_p, pool_s, hgrn_p, hgrn_s, conv_p, conv_s)
```

```cpp
#include <hip/hip_runtime.h>
#include <hip/hip_cooperative_groups.h>
#include <cstdint>
#include <cstdio>
namespace cg = cooperative_groups;


#ifndef MK_SINGLE
#define MK_SINGLE 1
#endif

typedef unsigned short bf16_t;
typedef short bf16x8 __attribute__((ext_vector_type(8)));
typedef float f32x4 __attribute__((ext_vector_type(4)));
typedef float f32x2 __attribute__((ext_vector_type(2)));
typedef unsigned u32x4 __attribute__((ext_vector_type(4)));
typedef unsigned u32x2 __attribute__((ext_vector_type(2)));
typedef _Float16 h16x4 __attribute__((ext_vector_type(4)));

constexpr int M_TOK = 33792, MP = 32768, DM = 1024, FF = 2816, SEQ = 8192, DSEQ = 64;
constexpr float EPS = 1e-6f;
constexpr int BM = 256, BK = 64, HALF = 128, HT = HALF * BK, NXCD = 8, WGM = 8;
constexpr int LDS_BYTES = 256 * 528;

constexpr size_t MiB = (size_t)1 << 20;
constexpr size_t WS_SSQ = 0;
constexpr size_t WS_LB = 2 * MiB;
constexpr size_t WS_DC = 3 * MiB;
constexpr size_t WS_W = 8 * MiB;
constexpr size_t WS_WUP = WS_W, WS_WDN = WS_W + 44 * MiB, WS_WIN = WS_W + 66 * MiB, WS_WOUT = WS_W + 82 * MiB, WS_WPOOL = WS_W + 86 * MiB;
constexpr size_t WS_XB = 96 * MiB;
constexpr size_t WS_SCR = 162 * MiB;
constexpr size_t WS_HID = WS_SCR, WS_DBUF = WS_SCR, WS_DS = WS_XB  ;
constexpr size_t WS_LF = WS_SCR + 66 * MiB, WS_QB = WS_SCR + 132 * MiB, WS_VB = WS_SCR + 198 * MiB, WS_GB = WS_SCR + 264 * MiB;
constexpr size_t WS_SSQP = WS_SCR + 330 * MiB;
constexpr size_t SSQ_STRIDE = (size_t)M_TOK * 16;
constexpr size_t WS_NEED = WS_SSQP + 9 * SSQ_STRIDE * 4;

constexpr size_t O_Y = 0, O_POOLP = 34603008, O_POOLS = 34725888, O_HGP = 35217408, O_HGS = 36265984, O_CVP = 40460288, O_CVS = 40550400;

struct Params { const float* in[18]; float* out; unsigned char* ws; };
enum { I_XP = 0, I_XS, I_SPOOL, I_SHG, I_SCONV, I_NMIXG, I_POOLW, I_POOLSC, I_HWIN, I_LBLOG, I_HNORMG, I_HWOUT, I_NFFNG, I_WUP, I_CONVW, I_CONVB, I_WDN, I_NOUTG };

extern __shared__ __attribute__((aligned(16))) unsigned char smem[];

typedef __bf16 bf16x2_t __attribute__((ext_vector_type(2)));
__device__ __forceinline__ unsigned cvt_pk_bf16(float lo, float hi) { const f32x2 v = {lo, hi}; const bf16x2_t b = __builtin_convertvector(v, bf16x2_t); return __builtin_bit_cast(unsigned, b); }
__device__ __forceinline__ float bf_lo(unsigned w) { return __uint_as_float(w << 16); }
__device__ __forceinline__ float bf_hi(unsigned w) { return __uint_as_float(w & 0xffff0000u); }
__device__ __forceinline__ float sigmoidf_(float z) { return __builtin_amdgcn_rcpf(1.0f + __expf(-z)); }
__device__ __forceinline__ float rstd_of(float ssq) { return rsqrtf(ssq * (1.0f / 1024.0f) + EPS); }
__device__ __forceinline__ float rstd_row(const float* sp) { const f32x4 a = *(const f32x4*)sp, b = *(const f32x4*)(sp + 4), c = *(const f32x4*)(sp + 8), d = *(const f32x4*)(sp + 12);
    const f32x4 t = (a + b) + (c + d); return rstd_of((t[0] + t[1]) + (t[2] + t[3])); }

__device__ __forceinline__ const char* uniform_ptr(const void* p) { const unsigned long long v = (unsigned long long)p; const unsigned lo = __builtin_amdgcn_readfirstlane((unsigned)v), hi = __builtin_amdgcn_readfirstlane((unsigned)(v >> 32)); return (const char*)(((unsigned long long)hi << 32) | lo); }
__device__ __forceinline__ void glds16(const char* sbase, unsigned voff, unsigned lds_addr) {
    unsigned keep; asm volatile("s_mov_b32 %0, m0\n\ts_mov_b32 m0, %3\n\ts_nop 4\n\tglobal_load_lds_dwordx4 %1, %2\n\ts_mov_b32 m0, %0" : "=&s"(keep) : "v"(voff), "s"(sbase), "s"(lds_addr) : "memory");
}
__device__ __forceinline__ int tid_launder(int wid_s) { int l; asm volatile("v_mbcnt_lo_u32_b32 %0, -1, 0\n\tv_mbcnt_hi_u32_b32 %0, -1, %0" : "=v"(l)); return wid_s * 64 + l; }

__device__ __forceinline__ int lds_byte(int r, int c) { int st = (r >> 4) * 2 + (c >> 5), rr = r & 15, cc = c & 31, ob = rr * 64 + cc * 2; return st * 1024 + (ob ^ (((ob >> 9) & 1) << 5)); }
__device__ __forceinline__ void stage_rc(int b, int& R, int& C) { int st = b / 1024, sb = b % 1024, swz = sb ^ (((sb >> 9) & 1) << 5); R = (st >> 1) * 16 + swz / 64; C = (st & 1) * 32 + (swz % 64) / 2; }

struct Unit { int pm, pn; };
__device__ __forceinline__ bool unit_next(int i, int nM, int nN, Unit& u) {
    const int nwg = nM * nN; const long L = (long)i * gridDim.x + blockIdx.x; if (L >= nwg) return false;
    int wgid = (int)L; { const int q = nwg / NXCD, r = nwg % NXCD, xcd = wgid % NXCD, off = wgid / NXCD; wgid = (xcd < r ? xcd * (q + 1) : r * (q + 1) + (xcd - r) * q) + off; }
    const int nig = WGM * nN, gid = wgid / nig, fm = gid * WGM, gsz = (nM - fm) < WGM ? (nM - fm) : WGM;
    u.pm = fm + ((wgid % nig) % gsz); u.pn = (wgid % nig) / gsz; return true;
}

struct GemmArgs { const bf16_t* A; const bf16_t* Bt; int lda, ldb, K, nM, nN; };

#define LAS __attribute__((address_space(3)))
template <class Epi>
__device__ __forceinline__ void gemm_phase(const GemmArgs g, const Epi& E, int wid_s) {
    LAS unsigned char* lds = (LAS unsigned char*)smem;
    constexpr int HTB = HT * 2;
#define SA(b, h) (((b) * 2 + (h)) * HTB)
#define SB(b, h) ((4 + (b) * 2 + (h)) * HTB)
#define STAGE(bufoff, gbase, voff) do { _Pragma("unroll") for (int _i = 0; _i < 2; ++_i) glds16((gbase), (voff)[_i], ldsb + (unsigned)((bufoff) + _i * 8192)); } while (0)
#define LDA(dst, b, h) do { _Pragma("unroll") for (int m = 0; m < 4; ++m) _Pragma("unroll") for (int k = 0; k < 2; ++k) dst[m][k] = *(const LAS bf16x8*)(lds + SA(b, h) + aoff + m * 2048 + k * 1024); } while (0)
#define LDB(dst, b, h) do { _Pragma("unroll") for (int n = 0; n < 2; ++n) _Pragma("unroll") for (int k = 0; k < 2; ++k) dst[n][k] = *(const LAS bf16x8*)(lds + SB(b, h) + boff + n * 2048 + k * 1024); } while (0)
#define MMA(ai, bj, At_, Bt_) do { __builtin_amdgcn_s_setprio(1); _Pragma("unroll") for (int m = 0; m < 4; ++m) _Pragma("unroll") for (int n = 0; n < 2; ++n) _Pragma("unroll") for (int k = 0; k < 2; ++k) \
      acc[ai][bj][m][n] = __builtin_amdgcn_mfma_f32_16x16x32_bf16(Bt_[n][k], At_[m][k], acc[ai][bj][m][n], 0, 0, 0); \
    __builtin_amdgcn_s_setprio(0); } while (0)
#define WAIT_V(n) asm volatile("s_waitcnt vmcnt(" #n ")" ::: "memory")
#define WAIT_L(n) asm volatile("s_waitcnt lgkmcnt(" #n ")" ::: "memory")
#define BAR __builtin_amdgcn_s_barrier()
#define SCHED __builtin_amdgcn_sched_barrier(0)
    const int tid = tid_launder(wid_s), wid = __builtin_amdgcn_readfirstlane(tid >> 6), lane = tid & 63, wr = wid >> 2, wc = wid & 3, fr = lane & 15, fq = lane >> 4;
    const int nt = g.K / BK;
    unsigned voffA[2], voffB[2];
#pragma unroll
    for (int i = 0; i < 2; ++i) { int R, C; stage_rc(tid * 16 + i * 8192, R, C); voffA[i] = (unsigned)(R * g.lda + C) * 2u; voffB[i] = (unsigned)(R * g.ldb + C) * 2u; }
    const size_t kstep = (size_t)(BK * 2), hstepA = (size_t)HALF * g.lda * 2, hstepB = (size_t)HALF * g.ldb * 2;
    const unsigned ldsb = (unsigned)__builtin_amdgcn_readfirstlane((int)(unsigned)(unsigned long long)(LAS unsigned char*)smem) + (unsigned)wid * 1024u;
    const int aoff = lds_byte(wr * 64 + fr, fq * 8), boff = lds_byte(wc * 32 + fr, fq * 8);
    Unit u;
    for (int it = 0; unit_next(it, g.nM, g.nN, u); ++it) {
        const char* cA = uniform_ptr(g.A + E.a_row0(u) * (long)g.lda + E.a_koff(u));
        const char* cB = uniform_ptr(g.Bt + (long)u.pn * BM * g.ldb);
        f32x4 acc[2][2][4][2];
#pragma unroll
        for (int a = 0; a < 2; ++a)
#pragma unroll
            for (int b = 0; b < 2; ++b)
#pragma unroll
                for (int m = 0; m < 4; ++m)
#pragma unroll
                    for (int n = 0; n < 2; ++n) acc[a][b][m][n] = (f32x4){0.f, 0.f, 0.f, 0.f};
        bf16x8 At[4][2], B0[2][2], B1[2][2];
        STAGE(SB(0, 0), cB, voffB); STAGE(SA(0, 0), cA, voffA); STAGE(SB(0, 1), cB + hstepB, voffB); STAGE(SA(0, 1), cA + hstepA, voffA);
        if (wr == 1) BAR;
        WAIT_V(4); BAR;
        STAGE(SB(1, 0), cB + kstep, voffB); STAGE(SA(1, 0), cA + kstep, voffA); STAGE(SB(1, 1), cB + hstepB + kstep, voffB);
        WAIT_V(6); BAR;
        for (int t = 0; t < nt - 2; t += 2) {
            const char* a1 = cA + (size_t)(t + 1) * kstep; const char* a2 = cA + (size_t)(t + 2) * kstep; const char* b2 = cB + (size_t)(t + 2) * kstep;
            const char* a3 = a2 + kstep; const char* b3 = b2 + kstep;
            LDB(B0, 0, 0); SCHED; LDA(At, 0, 0); STAGE(SA(1, 1), a1 + hstepA, voffA);
            WAIT_L(8); BAR; WAIT_L(0); MMA(0, 0, At, B0); BAR; SCHED;
            LDB(B1, 0, 1); STAGE(SB(0, 0), b2, voffB);
            BAR; WAIT_L(0); MMA(0, 1, At, B1); BAR;
            LDA(At, 0, 1); STAGE(SA(0, 0), a2, voffA);
            BAR; WAIT_L(0); MMA(1, 0, At, B0); BAR; SCHED;
            STAGE(SB(0, 1), b2 + hstepB, voffB);
            WAIT_V(6); BAR; MMA(1, 1, At, B1); BAR;
            LDB(B0, 1, 0); SCHED; LDA(At, 1, 0); STAGE(SA(0, 1), a2 + hstepA, voffA);
            WAIT_L(8); BAR; WAIT_L(0); MMA(0, 0, At, B0); BAR; SCHED;
            LDB(B1, 1, 1); STAGE(SB(1, 0), b3, voffB);
            BAR; WAIT_L(0); MMA(0, 1, At, B1); BAR;
            LDA(At, 1, 1); STAGE(SA(1, 0), a3, voffA);
            BAR; WAIT_L(0); MMA(1, 0, At, B0); BAR; SCHED;
            STAGE(SB(1, 1), b3 + hstepB, voffB);
            WAIT_V(6); BAR; MMA(1, 1, At, B1); BAR;
        }
        { LDB(B0, 0, 0); LDA(At, 0, 0); STAGE(SA(1, 1), cA + (size_t)(nt - 1) * kstep + hstepA, voffA);
          BAR; WAIT_L(0); MMA(0, 0, At, B0); BAR;
          LDB(B1, 0, 1); BAR; WAIT_L(0); MMA(0, 1, At, B1); BAR;
          LDA(At, 0, 1); WAIT_V(4); BAR; WAIT_L(0); MMA(1, 0, At, B0); MMA(1, 1, At, B1); BAR; }
        { LDB(B0, 1, 0); LDA(At, 1, 0); WAIT_V(2); BAR; WAIT_L(0); MMA(0, 0, At, B0); BAR;
          LDB(B1, 1, 1); WAIT_V(0); BAR; WAIT_L(0); MMA(0, 1, At, B1); BAR;
          LDA(At, 1, 1); BAR; WAIT_L(0); MMA(1, 0, At, B0); MMA(1, 1, At, B1); BAR; }
        if (wr == 0) BAR;
        { int l2_; asm volatile("v_mbcnt_lo_u32_b32 %0, -1, 0\n\tv_mbcnt_hi_u32_b32 %0, -1, %0" : "=v"(l2_)); const int fr_ = l2_ & 15, fq_ = l2_ >> 4;
          E(acc, u, wr, wc, fr_, fq_); }
        asm volatile("s_waitcnt vmcnt(0) lgkmcnt(0)" ::: "memory");
        __syncthreads();
    }
}

struct EpiResid {
    const float* xin_p; const float* xin_s; float* xf; bf16_t* xb; float* ssq; const float* colscale; int koff_per_pn;
    __device__ __forceinline__ long a_row0(const Unit& u) const { return (long)u.pm * BM; }
    __device__ __forceinline__ int a_koff(const Unit& u) const { return u.pn * koff_per_pn; }
    __device__ __forceinline__ void operator()(f32x4 (&acc)[2][2][4][2], const Unit& u, int wr, int wc, int fr, int fq) const {
#pragma unroll
        for (int ai = 0; ai < 2; ++ai)
#pragma unroll
            for (int m = 0; m < 4; ++m) {
                const int row = u.pm * BM + ai * HALF + wr * 64 + m * 16 + fr;
                const float* xr = row < MP ? xin_p + (size_t)row * DM : xin_s + (size_t)(row - MP) * DM;
                float ss = 0.f;
#pragma unroll
                for (int bj = 0; bj < 2; ++bj)
#pragma unroll
                    for (int n = 0; n < 2; ++n) {
                        const int col = u.pn * BM + bj * HALF + wc * 32 + n * 16 + fq * 4;
                        f32x4 v = acc[ai][bj][m][n];
                        if (colscale) v = v * *(const f32x4*)(colscale + col);
                        v = v + *(const f32x4*)(xr + col);
                        *(f32x4*)(xf + (size_t)row * DM + col) = v;
                        u32x2 w; w.x = cvt_pk_bf16(v[0], v[1]); w.y = cvt_pk_bf16(v[2], v[3]);
                        *(u32x2*)(xb + (size_t)row * DM + col) = w;
                        ss += (v[0] * v[0] + v[1] * v[1]) + (v[2] * v[2] + v[3] * v[3]);
                    }
                ss += __shfl_xor(ss, 16); ss += __shfl_xor(ss, 32);
                if (fq == 0) ssq[(size_t)row * 16 + u.pn * 4 + wc] = ss;
                asm volatile("" ::: "memory");
            }
    }
};

struct EpiHin {
    const float* ssq; const float* lb; unsigned char* ws;
    __device__ __forceinline__ long a_row0(const Unit& u) const { return (long)u.pm * BM; }
    __device__ __forceinline__ int a_koff(const Unit&) const { return 0; }
    __device__ __forceinline__ void operator()(f32x4 (&acc)[2][2][4][2], const Unit& u, int wr, int wc, int fr, int fq) const {
        const int sec = u.pn >> 2;
#pragma unroll
        for (int ai = 0; ai < 2; ++ai)
#pragma unroll
            for (int m = 0; m < 4; ++m) {
                const int row = u.pm * BM + ai * HALF + wr * 64 + m * 16 + fr;
                const float rs = rstd_row(ssq + (size_t)row * 16);
#pragma unroll
                for (int bj = 0; bj < 2; ++bj)
#pragma unroll
                    for (int n = 0; n < 2; ++n) {
                        const int cs = (u.pn & 3) * BM + bj * HALF + wc * 32 + n * 16 + fq * 4;
                        const f32x4 z = acc[ai][bj][m][n] * rs;
                        const size_t o = (size_t)row * DM + cs;
                        if (sec == 1) {
                            const f32x4 l4 = *(const f32x4*)(lb + cs); h16x4 h;
#pragma unroll
                            for (int j = 0; j < 4; ++j) { const float f = l4[j] + (1.0f - l4[j]) * sigmoidf_(z[j]); h[j] = (_Float16)__logf(f); }
                            *(h16x4*)((_Float16*)(ws + WS_LF) + o) = h;
                        } else {
                            f32x4 r = z;
                            if (sec != 2) {
#pragma unroll
                                for (int j = 0; j < 4; ++j) r[j] = z[j] * sigmoidf_(z[j]);
                            }
                            u32x2 w; w.x = cvt_pk_bf16(r[0], r[1]); w.y = cvt_pk_bf16(r[2], r[3]);
                            bf16_t* dst = (bf16_t*)(ws + WS_QB + (size_t)(sec == 0 ? 0 : sec - 1) * (66 * MiB));
                            *(u32x2*)(dst + o) = w;
                        }
                    }
            }
    }
};

struct EpiUp {
    const float* ssq; const float* cw; const float* cb; const float* hist; bf16_t* hid; float* cvp; float* cvs;
    __device__ __forceinline__ long a_row0(const Unit& u) const { return u.pm < 132 ? (long)(u.pm / 33) * SEQ + 254 * (u.pm % 33) - 2 : (long)MP + 256 * (u.pm - 132); }
    __device__ __forceinline__ int a_koff(const Unit&) const { return 0; }
    __device__ __forceinline__ void operator()(f32x4 (&acc)[2][2][4][2], const Unit& u, int wr, int wc, int fr, int fq) const {
        float* G = (float*)smem;
        const bool prompt = u.pm < 132; const int tt = u.pm % 33;
        const long rbase = a_row0(u);
        const long row_end = prompt ? (long)(u.pm / 33 + 1) * SEQ : (long)M_TOK;
#pragma unroll
        for (int ai = 0; ai < 2; ++ai)
#pragma unroll
            for (int m = 0; m < 4; ++m) {
                const int lrow = ai * HALF + wr * 64 + m * 16 + fr; long gr = rbase + lrow; if (gr < 0) gr = 0;
                const float rsv = rstd_row(ssq + (size_t)gr * 16);
                const bool zero = prompt && tt == 0 && lrow < 2;
#pragma unroll
                for (int n = 0; n < 2; ++n) {
                    f32x4 gv = acc[ai][0][m][n] * rsv; acc[ai][1][m][n] = acc[ai][1][m][n] * rsv; if (zero) gv = (f32x4){0.f, 0.f, 0.f, 0.f};
                    acc[ai][0][m][n] = gv;
                    *(f32x4*)(G + lrow * 132 + wc * 32 + n * 16 + fq * 4) = gv;
                }
            }
        __syncthreads();
#pragma unroll
        for (int n = 0; n < 2; ++n) {
            const int cl = wc * 32 + n * 16 + fq * 4, c = u.pn * HALF + cl;
            const f32x4 w0 = *(const f32x4*)(cw + c), w1 = *(const f32x4*)(cw + FF + c), w2 = *(const f32x4*)(cw + 2 * FF + c), bb = *(const f32x4*)(cb + c);
#pragma unroll
            for (int ai = 0; ai < 2; ++ai)
#pragma unroll
                for (int m = 0; m < 4; ++m) {
                    const int lrow = ai * HALF + wr * 64 + m * 16 + fr; const long gr = rbase + lrow;
                    const bool valid = prompt ? (lrow >= 2 && gr < row_end) : true;
                    if (valid) {
                        f32x4 g1, g2; const f32x4 g0 = acc[ai][0][m][n];
                        if (prompt || (lrow & 63) >= 2) { g1 = *(const f32x4*)(G + (lrow - 1) * 132 + cl); g2 = *(const f32x4*)(G + (lrow - 2) * 132 + cl); }
                        else {
                            const int b = (int)(gr - MP) >> 6; const float* hb = hist + (size_t)b * 2 * FF + c;
                            if ((lrow & 63) == 0) { g2 = *(const f32x4*)(hb); g1 = *(const f32x4*)(hb + FF); }
                            else { g2 = *(const f32x4*)(hb + FF); g1 = *(const f32x4*)(G + (lrow - 1) * 132 + cl); }
                        }
                        const f32x4 cv = bb + w0 * g2 + w1 * g1 + w2 * g0;
                        const f32x4 vv = acc[ai][1][m][n];
                        f32x4 h;
#pragma unroll
                        for (int j = 0; j < 4; ++j) h[j] = cv[j] * sigmoidf_(cv[j]) * vv[j];
                        u32x2 w; w.x = cvt_pk_bf16(h[0], h[1]); w.y = cvt_pk_bf16(h[2], h[3]);
                        *(u32x2*)(hid + (size_t)gr * FF + c) = w;
                        if (prompt) { const int l = (int)(gr & (SEQ - 1)); if (l >= SEQ - 2) *(f32x4*)(cvp + ((size_t)(gr >> 13) * 2 + (l - (SEQ - 2))) * FF + c) = g0; }
                        else { const int l = (int)(gr & 63); if (l >= 62) *(f32x4*)(cvs + ((size_t)((gr - MP) >> 6) * 2 + (l - 62)) * FF + c) = g0; }
                    }
                    asm volatile("" ::: "memory");
                }
        }
    }
};

__device__ __forceinline__ void prep_tile(const float* W, int K, int N, const float* gk, bf16_t* Wt, int k0, int n0, int nd0, int wid_s) {
    bf16_t* T = (bf16_t*)smem;
    const int tid = tid_launder(wid_s);
#pragma unroll
    for (int i = 0; i < 8; ++i) {
        const int k = i * 16 + (tid >> 5), n4 = (tid & 31) * 4;
        f32x4 v = *(const f32x4*)(W + (size_t)(k0 + k) * N + n0 + n4);
        if (gk) v = v * gk[k0 + k];
        const unsigned p0 = cvt_pk_bf16(v[0], v[1]), p1 = cvt_pk_bf16(v[2], v[3]);
        T[(n4 + 0) * 136 + k] = (bf16_t)(p0 & 0xffff); T[(n4 + 1) * 136 + k] = (bf16_t)(p0 >> 16);
        T[(n4 + 2) * 136 + k] = (bf16_t)(p1 & 0xffff); T[(n4 + 3) * 136 + k] = (bf16_t)(p1 >> 16);
    }
    __syncthreads();
#pragma unroll
    for (int i = 0; i < 4; ++i) {
        const int n = i * 32 + (tid >> 4), kq = (tid & 15) * 8;
        const u32x4 v = *(const u32x4*)(T + n * 136 + kq);
        *(u32x4*)(Wt + (size_t)(nd0 + n) * K + k0 + kq) = v;
    }
    __syncthreads();
}

__device__ __forceinline__ void phase_prep(const Params& p, int wid_s) {
    unsigned char* ws = p.ws;
    for (int t = blockIdx.x; t < 2784; t += gridDim.x) {
        const float* W; const float* gk = nullptr; bf16_t* Wt; int K, N, lt, mode = 0;
        if (t < 1408) { const int L = t / 352; lt = t % 352; K = DM; N = 2 * FF; W = p.in[I_WUP] + (size_t)L * DM * 2 * FF; gk = p.in[I_NFFNG] + L * DM; Wt = (bf16_t*)(ws + WS_WUP) + (size_t)L * 2 * FF * DM; mode = 1; }
        else if (t < 2112) { const int L = (t - 1408) / 176; lt = (t - 1408) % 176; K = FF; N = DM; W = p.in[I_WDN] + (size_t)L * FF * DM; Wt = (bf16_t*)(ws + WS_WDN) + (size_t)L * DM * FF; }
        else if (t < 2624) { const int j = (t - 2112) / 256; lt = (t - 2112) % 256; K = DM; N = 4 * DM; W = p.in[I_HWIN] + (size_t)j * DM * 4 * DM; gk = p.in[I_NMIXG] + (2 * j + 1) * DM; Wt = (bf16_t*)(ws + WS_WIN) + (size_t)j * 4 * DM * DM; }
        else if (t < 2752) { const int j = (t - 2624) / 64; lt = (t - 2624) % 64; K = DM; N = DM; W = p.in[I_HWOUT] + (size_t)j * DM * DM; Wt = (bf16_t*)(ws + WS_WOUT) + (size_t)j * DM * DM; }
        else { const int mg = (t - 2752) / 4; lt = (t - 2752) % 4; K = 256; N = 256; W = p.in[I_POOLW] + (size_t)mg * 65536; Wt = (bf16_t*)(ws + WS_WPOOL) + (size_t)mg * 65536; }
        const int nkb = K / 128, kb = lt % nkb, nb = lt / nkb;
        int nd0 = nb * 128; if (mode == 1) nd0 = nb < 22 ? nb * 256 : (nb - 22) * 256 + 128;
        prep_tile(W, K, N, gk, Wt, kb * 128, nb * 128, nd0, wid_s);
    }
    const int tidp = tid_launder(wid_s); const int gtid = blockIdx.x * blockDim.x + tidp, gsz = gridDim.x * blockDim.x;
    for (int c = gtid; c < DM; c += gsz) {
        const float* lg = p.in[I_LBLOG]; float a0 = lg[c], a1 = lg[DM + c], a2 = lg[2 * DM + c], a3 = lg[3 * DM + c];
        const float mx = fmaxf(fmaxf(a0, a1), fmaxf(a2, a3)); a0 = expf(a0 - mx); a1 = expf(a1 - mx); a2 = expf(a2 - mx); a3 = expf(a3 - mx);
        const float inv = 1.0f / (a0 + a1 + a2 + a3); float* lb = (float*)(ws + WS_LB);
        lb[c] = 0.f; lb[DM + c] = a1 * inv; lb[2 * DM + c] = (a1 + a2) * inv; lb[3 * DM + c] = (a1 + a2 + a3) * inv;
    }
    const int wv = gtid >> 6, nwv = gsz >> 6, lane = tidp & 63;
    bf16_t* xb = (bf16_t*)(ws + WS_XB); float* ssq0 = (float*)(ws + WS_SSQP);
    for (int row = wv; row < M_TOK; row += nwv) {
        const float* xr = row < MP ? p.in[I_XP] + (size_t)row * DM : p.in[I_XS] + (size_t)(row - MP) * DM;
        float ss = 0.f;
#pragma unroll
        for (int i = 0; i < 4; ++i) {
            const f32x4 v = *(const f32x4*)(xr + i * 256 + lane * 4);
            ss += (v[0] * v[0] + v[1] * v[1]) + (v[2] * v[2] + v[3] * v[3]);
            u32x2 w; w.x = cvt_pk_bf16(v[0], v[1]); w.y = cvt_pk_bf16(v[2], v[3]);
            *(u32x2*)(xb + (size_t)row * DM + i * 256 + lane * 4) = w;
        }
#pragma unroll
        for (int o = 32; o >= 1; o >>= 1) ss += __shfl_xor(ss, o);
        if (lane < 16) ssq0[(size_t)row * 16 + lane] = lane == 0 ? ss : 0.f;
    }
}

template <int WIN>
__device__ __forceinline__ void pool_walk(const Params& p, int L, int sgi, const float* rsT, int tid) {
    const int  c0 = tid * 2, j = L >> 1;
    const int R0 = sgi * 64; const bool prompt = R0 < MP;
    const int b = prompt ? R0 >> 13 : (R0 - MP) >> 6, l0 = prompt ? (R0 & (SEQ - 1)) : 0, Lseq = prompt ? SEQ : DSEQ;
    const bf16_t* xb = (const bf16_t*)(p.ws + WS_XB); bf16_t* dbuf = (bf16_t*)(p.ws + WS_DBUF);
    const f32x2 g2 = *(const f32x2*)(p.in[I_NMIXG] + L * DM + c0);
    const float* hist = p.in[I_SPOOL] + ((size_t)j * 16 + b) * 15 * DM + c0;
    float* outp = prompt ? p.out + O_POOLP + ((size_t)j * 4 + b) * 15 * DM + c0 : p.out + O_POOLS + ((size_t)j * 16 + b) * 15 * DM + c0;
    float r0[16], r1[16]; float s0 = 0.f, s1 = 0.f;
#pragma unroll
    for (int k = 0; k < 16; ++k) { r0[k] = 0.f; r1[k] = 0.f; }
    for (int blk = 0; blk < 5; ++blk) {
#pragma unroll
        for (int k = 0; k < 16; ++k) {
            const int i = blk * 16 + k;
            if (i < 79) {
                const int li = l0 - 15 + i;
                float h0 = 0.f, h1 = 0.f;
                if (li >= 0) { const unsigned w = *(const unsigned*)(xb + (size_t)(R0 - 15 + i) * DM + c0); const float rs = rsT[i]; h0 = bf_lo(w) * rs * g2.x; h1 = bf_hi(w) * rs * g2.y; }
                else if (!prompt) { const f32x2 hv = *(const f32x2*)(hist + (size_t)i * DM); h0 = hv.x; h1 = hv.y; }
                s0 += h0 - r0[(k - WIN) & 15]; s1 += h1 - r1[(k - WIN) & 15];
                r0[k] = h0; r1[k] = h1;
                if (i >= 15) {
                    const int cnt = prompt ? (li + 1 < WIN ? li + 1 : WIN) : WIN; const float inv = 1.0f / (float)cnt;
                    *(unsigned*)(dbuf + (size_t)(R0 + i - 15) * DM + c0) = cvt_pk_bf16(s0 * inv - h0, s1 * inv - h1);
                    if (li >= Lseq - 15) *(f32x2*)(outp + (size_t)(li - (Lseq - 15)) * DM) = (f32x2){h0, h1};
                }
            }
        }
    }
}
__device__ __forceinline__ void phase_pool_d(const Params& p, int L, int wid_s) {
    float* rsT = (float*)smem; const float* ssq = (const float*)(p.ws + WS_SSQP) + (size_t)(2 * L) * SSQ_STRIDE;
    const int tid = tid_launder(wid_s);
    for (int sgi = blockIdx.x; sgi < M_TOK / 64; sgi += gridDim.x) {
        const int R0 = sgi * 64;
        __syncthreads();
        if (tid < 79) { const int r = R0 - 15 + tid; rsT[tid] = rstd_row(ssq + (size_t)(r < 0 ? 0 : r) * 16); }
        __syncthreads();
        switch (tid >> 7) { case 0: pool_walk<2>(p, L, sgi, rsT, tid); break; case 1: pool_walk<4>(p, L, sgi, rsT, tid); break; case 2: pool_walk<8>(p, L, sgi, rsT, tid); break; default: pool_walk<16>(p, L, sgi, rsT, tid); break; }
    }
}

struct ChunkB { float lf[4][4]; float b[4][4]; float bref[4]; float bC[4]; };
__device__ __forceinline__ void chunk_cumsum(const _Float16* lfp  , ChunkB& cb, float* T  , int tid) {
    const int cg = tid & 31, rg = tid >> 5;
#pragma unroll
    for (int i = 0; i < 4; ++i) { const h16x4 h = *(const h16x4*)(lfp + (size_t)(4 * rg + i) * DM + 4 * cg);
#pragma unroll
        for (int j = 0; j < 4; ++j) cb.lf[i][j] = (float)h[j]; }
#pragma unroll
    for (int j = 0; j < 4; ++j) { cb.b[0][j] = cb.lf[0][j]; cb.b[1][j] = cb.b[0][j] + cb.lf[1][j]; cb.b[2][j] = cb.b[1][j] + cb.lf[2][j]; cb.b[3][j] = cb.b[2][j] + cb.lf[3][j]; }
    *(f32x4*)(T + rg * 128 + 4 * cg) = (f32x4){cb.b[3][0], cb.b[3][1], cb.b[3][2], cb.b[3][3]};
    __syncthreads();
    f32x4 off = {0.f, 0.f, 0.f, 0.f}, br = {0.f, 0.f, 0.f, 0.f}, bc = {0.f, 0.f, 0.f, 0.f};
#pragma unroll
    for (int r = 0; r < 16; ++r) { const f32x4 t = *(const f32x4*)(T + r * 128 + 4 * cg); if (r < rg) off = off + t; if (r < 8) br = br + t; bc = bc + t; }
#pragma unroll
    for (int j = 0; j < 4; ++j) { cb.bref[j] = br[j]; cb.bC[j] = bc[j];
#pragma unroll
        for (int i = 0; i < 4; ++i) cb.b[i][j] += off[j]; }
}

__device__ __forceinline__ void phase_hds(const Params& p, int wid_s) {
    unsigned char* ws = p.ws;
    float* T = (float*)smem;
    unsigned char* KdT = smem + 8192;
    unsigned char* Vt = KdT + 128 * 144;
    const _Float16* lf = (const _Float16*)(ws + WS_LF); const bf16_t* vb = (const bf16_t*)(ws + WS_VB);
    bf16_t* dS = (bf16_t*)(ws + WS_DS); float* dc = (float*)(ws + WS_DC);
    const int tid = tid_launder(wid_s), cg = tid & 31, rg = tid >> 5, wid = tid >> 6, lane = tid & 63, fr = lane & 15, fq = lane >> 4;
    for (int u = blockIdx.x; u < 4224; u += gridDim.x) {
        const int c = u >> 3, h = u & 7; const size_t org = (size_t)c * 64 * DM + h * 128;
        __syncthreads();
        ChunkB cb; chunk_cumsum(lf + org, cb, T, tid);
        float kd[4][4]; unsigned vw[4][2];
#pragma unroll
        for (int i = 0; i < 4; ++i) { const u32x2 w = *(const u32x2*)(vb + org + (size_t)(4 * rg + i) * DM + 4 * cg); vw[i][0] = w.x; vw[i][1] = w.y;
#pragma unroll
            for (int j = 0; j < 4; ++j) kd[i][j] = (1.0f - __expf(cb.lf[i][j])) * __expf(cb.bC[j] - cb.b[i][j]); }
#pragma unroll
        for (int j = 0; j < 4; ++j) {
            u32x2 w; w.x = cvt_pk_bf16(kd[0][j], kd[1][j]); w.y = cvt_pk_bf16(kd[2][j], kd[3][j]);
            *(u32x2*)(KdT + (4 * cg + j) * 144 + rg * 8) = w;
            unsigned short e[4];
#pragma unroll
            for (int i = 0; i < 4; ++i) e[i] = (unsigned short)((j & 1) ? (vw[i][j >> 1] >> 16) : (vw[i][j >> 1] & 0xffff));
            u32x2 x; x.x = (unsigned)e[0] | ((unsigned)e[1] << 16); x.y = (unsigned)e[2] | ((unsigned)e[3] << 16);
            *(u32x2*)(Vt + (4 * cg + j) * 144 + rg * 8) = x;
        }
        if (rg == 0) *(f32x4*)(dc + (size_t)u * 128 + 4 * cg) = (f32x4){__expf(cb.bC[0]), __expf(cb.bC[1]), __expf(cb.bC[2]), __expf(cb.bC[3])};
        __syncthreads();
        bf16x8 bv[2];
#pragma unroll
        for (int ks = 0; ks < 2; ++ks) bv[ks] = *(const bf16x8*)(Vt + (wid * 16 + fr) * 144 + ks * 64 + fq * 16);
#pragma unroll
        for (int kb = 0; kb < 8; ++kb) {
            f32x4 a = {0.f, 0.f, 0.f, 0.f};
#pragma unroll
            for (int ks = 0; ks < 2; ++ks) { const bf16x8 af = *(const bf16x8*)(KdT + (kb * 16 + fr) * 144 + ks * 64 + fq * 16); a = __builtin_amdgcn_mfma_f32_16x16x32_bf16(af, bv[ks], a, 0, 0, 0); }
            u32x2 w; w.x = cvt_pk_bf16(a[0], a[1]); w.y = cvt_pk_bf16(a[2], a[3]);
            *(u32x2*)(dS + ((size_t)u * 128 + wid * 16 + fr) * 128 + kb * 16 + fq * 4) = w;
        }
    }
}

__device__ __forceinline__ void phase_hscan(const Params& p, int L, int wid_s) {
    unsigned char* ws = p.ws; const int j = L >> 1;
    bf16_t* dS = (bf16_t*)(ws + WS_DS); const float* dc = (const float*)(ws + WS_DC);
    const int gtid = blockIdx.x * blockDim.x + tid_launder(wid_s), gsz = gridDim.x * blockDim.x;
    for (int task = gtid; task < 32 * 4096; task += gsz) {
        const int kq = task & 31, v = (task >> 5) & 127, bh = task >> 12, b = bh >> 3, h = bh & 7;
        f32x4 S = {0.f, 0.f, 0.f, 0.f};
        const size_t ustride = (size_t)8 * 16384; bf16_t* ptr = dS + ((size_t)(b * 128) * 8 + h) * 16384 + v * 128 + kq * 4;
        const float* dptr = dc + ((size_t)(b * 128) * 8 + h) * 128 + kq * 4;
        u32x2 w[8]; f32x4 d[8];
#pragma unroll
        for (int i = 0; i < 8; ++i) { w[i] = *(const u32x2*)(ptr + i * ustride); d[i] = *(const f32x4*)(dptr + (size_t)i * 8 * 128); }
        for (int c0 = 0; c0 < 128; c0 += 8) {
            u32x2 wn[8]; f32x4 dn[8];
            if (c0 + 8 < 128) {
#pragma unroll
                for (int i = 0; i < 8; ++i) { wn[i] = *(const u32x2*)(ptr + (size_t)(c0 + 8 + i) * ustride); dn[i] = *(const f32x4*)(dptr + (size_t)(c0 + 8 + i) * 8 * 128); }
            } else {
#pragma unroll
                for (int i = 0; i < 8; ++i) { wn[i] = (u32x2){0u, 0u}; dn[i] = (f32x4){0.f, 0.f, 0.f, 0.f}; }
            }
#pragma unroll
            for (int i = 0; i < 8; ++i) {
                u32x2 o; o.x = cvt_pk_bf16(S[0], S[1]); o.y = cvt_pk_bf16(S[2], S[3]);
#ifndef DIAG_NOSTORE
                *(u32x2*)(ptr + (size_t)(c0 + i) * ustride) = o;
#endif
                const f32x4 ds = {bf_lo(w[i].x), bf_hi(w[i].x), bf_lo(w[i].y), bf_hi(w[i].y)};
                S = d[i] * S + ds;
            }
#pragma unroll
            for (int i = 0; i < 8; ++i) { w[i] = wn[i]; d[i] = dn[i]; }
        }
        float* o = p.out + O_HGP + (((size_t)j * 4 + b) * 8 + h) * 16384 + (size_t)(kq * 4) * 128 + v;
        o[0] = S[0]; o[128] = S[1]; o[256] = S[2]; o[384] = S[3];
    }
#ifndef NO_SAMPLE_SCAN
    for (int task = gtid; task < 128 * 4096; task += gsz) {
        const int vq = task & 31, k = (task >> 5) & 127, bh = task >> 12, b = bh >> 3, h = bh & 7;
        const int u = (512 + b) * 8 + h;
        const size_t so = (((size_t)j * 16 + b) * 8 + h) * 16384 + (size_t)k * 128 + vq * 4;
        const f32x4 S0 = *(const f32x4*)(p.in[I_SHG] + so);
        const float dk = dc[(size_t)u * 128 + k];
        bf16_t* ptr = dS + (size_t)u * 16384 + (size_t)(vq * 4) * 128 + k;
        f32x4 Sf;
#pragma unroll
        for (int i = 0; i < 4; ++i) { const float ds = __uint_as_float((unsigned)ptr[i * 128] << 16); Sf[i] = dk * S0[i] + ds; ptr[i * 128] = (bf16_t)(cvt_pk_bf16(S0[i], 0.f) & 0xffff); }
        *(f32x4*)(p.out + O_HGS + so) = Sf;
    }
#endif
}

__device__ __forceinline__ void phase_hout(const Params& p, int L, int wid_s) {
    unsigned char* ws = p.ws; const int jj = L >> 1;
    float* T = (float*)smem;
    unsigned char* Q1 = smem + 8192;
    unsigned char* Q2 = Q1 + 64 * 272;
    unsigned char* K1 = Q2 + 64 * 272;
    unsigned char* Vt = K1 + 64 * 272;
    unsigned char* St = Vt + 128 * 144;
    unsigned char* Ab = St + 128 * 272;
    float* red = (float*)(Ab + 64 * 144);
    const _Float16* lf = (const _Float16*)(ws + WS_LF); const bf16_t* vb = (const bf16_t*)(ws + WS_VB); const bf16_t* gb = (const bf16_t*)(ws + WS_GB);
    bf16_t* qb = (bf16_t*)(ws + WS_QB); const bf16_t* Sc = (const bf16_t*)(ws + WS_DS);
    const float* gn = p.in[I_HNORMG] + jj * DM;
    const int tid = tid_launder(wid_s), cg = tid & 31, rg = tid >> 5, wid = tid >> 6, lane = tid & 63, fr = lane & 15, fq = lane >> 4;
    for (int u = blockIdx.x; u < 4224; u += gridDim.x) {
        const int c = u >> 3, h = u & 7; const size_t org = (size_t)c * 64 * DM + h * 128;
        __syncthreads();
        ChunkB cb; chunk_cumsum(lf + org, cb, T, tid);
#pragma unroll
        for (int i = 0; i < 4; ++i) { const int idx = tid + 512 * i, r = idx >> 4, c8 = (idx & 15) * 8; *(u32x4*)(St + r * 272 + c8 * 2) = *(const u32x4*)(Sc + (size_t)u * 16384 + r * 128 + c8); }
        unsigned vw[4][2];
#pragma unroll
        for (int i = 0; i < 4; ++i) {
            const size_t o = org + (size_t)(4 * rg + i) * DM + 4 * cg;
            const u32x2 qw = *(const u32x2*)(qb + o); const u32x2 w = *(const u32x2*)(vb + o); vw[i][0] = w.x; vw[i][1] = w.y;
            const float q[4] = {bf_lo(qw.x), bf_hi(qw.x), bf_lo(qw.y), bf_hi(qw.y)};
            float q1[4], q2[4], k1[4];
#pragma unroll
            for (int j = 0; j < 4; ++j) { const float kk = 1.0f - __expf(cb.lf[i][j]); q1[j] = q[j] * __expf(cb.b[i][j] - cb.bref[j]); q2[j] = q[j] * __expf(cb.b[i][j]); k1[j] = kk * __expf(cb.bref[j] - cb.b[i][j]); }
            u32x2 a; a.x = cvt_pk_bf16(q1[0], q1[1]); a.y = cvt_pk_bf16(q1[2], q1[3]); *(u32x2*)(Q1 + (4 * rg + i) * 272 + cg * 8) = a;
            a.x = cvt_pk_bf16(q2[0], q2[1]); a.y = cvt_pk_bf16(q2[2], q2[3]); *(u32x2*)(Q2 + (4 * rg + i) * 272 + cg * 8) = a;
            a.x = cvt_pk_bf16(k1[0], k1[1]); a.y = cvt_pk_bf16(k1[2], k1[3]); *(u32x2*)(K1 + (4 * rg + i) * 272 + cg * 8) = a;
        }
#pragma unroll
        for (int j = 0; j < 4; ++j) {
            unsigned short e[4];
#pragma unroll
            for (int i = 0; i < 4; ++i) e[i] = (unsigned short)((j & 1) ? (vw[i][j >> 1] >> 16) : (vw[i][j >> 1] & 0xffff));
            u32x2 x; x.x = (unsigned)e[0] | ((unsigned)e[1] << 16); x.y = (unsigned)e[2] | ((unsigned)e[3] << 16);
            *(u32x2*)(Vt + (4 * cg + j) * 144 + rg * 8) = x;
        }
        __syncthreads();
        const int tb = wid & 3, hv = wid >> 2;
#pragma unroll
        for (int q = 0; q < 2; ++q) {
            const int sb = hv * 2 + q; f32x4 a = {0.f, 0.f, 0.f, 0.f};
            if (sb <= tb) {
#pragma unroll
                for (int ks = 0; ks < 4; ++ks) { const bf16x8 af = *(const bf16x8*)(K1 + (sb * 16 + fr) * 272 + ks * 64 + fq * 16); const bf16x8 bf = *(const bf16x8*)(Q1 + (tb * 16 + fr) * 272 + ks * 64 + fq * 16);
                    a = __builtin_amdgcn_mfma_f32_16x16x32_bf16(af, bf, a, 0, 0, 0); }
#pragma unroll
                for (int r = 0; r < 4; ++r) if (sb * 16 + fq * 4 + r > tb * 16 + fr) a[r] = 0.f;
            }
            u32x2 w; w.x = cvt_pk_bf16(a[0], a[1]); w.y = cvt_pk_bf16(a[2], a[3]);
            *(u32x2*)(Ab + (tb * 16 + fr) * 144 + sb * 32 + fq * 8) = w;
        }
        f32x4 o4[4];
#pragma unroll
        for (int vi = 0; vi < 4; ++vi) o4[vi] = (f32x4){0.f, 0.f, 0.f, 0.f};
#pragma unroll
        for (int ks = 0; ks < 4; ++ks) { const bf16x8 bf = *(const bf16x8*)(Q2 + (tb * 16 + fr) * 272 + ks * 64 + fq * 16);
#pragma unroll
            for (int vi = 0; vi < 4; ++vi) { const bf16x8 af = *(const bf16x8*)(St + ((hv * 4 + vi) * 16 + fr) * 272 + ks * 64 + fq * 16); o4[vi] = __builtin_amdgcn_mfma_f32_16x16x32_bf16(af, bf, o4[vi], 0, 0, 0); } }
        __syncthreads();
#pragma unroll
        for (int ks = 0; ks < 2; ++ks) { const bf16x8 bf = *(const bf16x8*)(Ab + (tb * 16 + fr) * 144 + ks * 64 + fq * 16);
#pragma unroll
            for (int vi = 0; vi < 4; ++vi) { const bf16x8 af = *(const bf16x8*)(Vt + ((hv * 4 + vi) * 16 + fr) * 144 + ks * 64 + fq * 16); o4[vi] = __builtin_amdgcn_mfma_f32_16x16x32_bf16(af, bf, o4[vi], 0, 0, 0); } }
        float ss = 0.f;
#pragma unroll
        for (int vi = 0; vi < 4; ++vi) ss += (o4[vi][0] * o4[vi][0] + o4[vi][1] * o4[vi][1]) + (o4[vi][2] * o4[vi][2] + o4[vi][3] * o4[vi][3]);
        ss += __shfl_xor(ss, 16); ss += __shfl_xor(ss, 32);
        if (fq == 0) red[hv * 64 + tb * 16 + fr] = ss;
        __syncthreads();
        const float rs = rsqrtf((red[tb * 16 + fr] + red[64 + tb * 16 + fr]) * (1.0f / 128.0f) + EPS);
        const size_t orow = org + (size_t)(tb * 16 + fr) * DM;
#pragma unroll
        for (int vi = 0; vi < 4; ++vi) {
            const int vc = (hv * 4 + vi) * 16 + fq * 4;
            const f32x4 g4 = *(const f32x4*)(gn + h * 128 + vc); const u32x2 gw = *(const u32x2*)(gb + orow + vc);
            const float r0 = o4[vi][0] * rs * g4[0] * bf_lo(gw.x), r1 = o4[vi][1] * rs * g4[1] * bf_hi(gw.x), r2 = o4[vi][2] * rs * g4[2] * bf_lo(gw.y), r3 = o4[vi][3] * rs * g4[3] * bf_hi(gw.y);
            u32x2 w; w.x = cvt_pk_bf16(r0, r1); w.y = cvt_pk_bf16(r2, r3);
            *(u32x2*)(qb + orow + vc) = w;
        }
    }
}

__device__ __forceinline__ void phase_final(const Params& p, int wid_s) {
    const int tidf = tid_launder(wid_s); const int gtid = blockIdx.x * blockDim.x + tidf, gsz = gridDim.x * blockDim.x, wv = gtid >> 6, nwv = gsz >> 6, lane = tidf & 63;
    const float* ssq = (const float*)(p.ws + WS_SSQP) + (size_t)8 * SSQ_STRIDE; const float* g = p.in[I_NOUTG];
    for (int row = wv; row < M_TOK; row += nwv) {
        const float rs = rstd_row(ssq + (size_t)row * 16); float* xr = p.out + O_Y + (size_t)row * DM;
#pragma unroll
        for (int i = 0; i < 4; ++i) { const int c = i * 256 + lane * 4; f32x4 v = *(const f32x4*)(xr + c); v = v * rs * *(const f32x4*)(g + c); *(f32x4*)(xr + c) = v; }
    }
}

enum { OP_PREP = 0, OP_POOLD, OP_POOLG, OP_HIN, OP_HDS, OP_HSCAN, OP_HOUT, OP_HPROJ, OP_UP, OP_DOWN, OP_FINAL };
constexpr int NPH = 24;
__device__ __forceinline__ void phase_decode(int ph, int& op, int& L) {
    if (ph == 0) { op = OP_PREP; L = 0; return; }
    if (ph == 23) { op = OP_FINAL; L = 0; return; }
    int q = ph - 1;
    const int pr = q / 11; q %= 11;
    if (q < 4) { L = 2 * pr; op = q == 0 ? OP_POOLD : q == 1 ? OP_POOLG : q == 2 ? OP_UP : OP_DOWN; }
    else { q -= 4; L = 2 * pr + 1; op = q == 0 ? OP_HIN : q == 1 ? OP_HDS : q == 2 ? OP_HSCAN : q == 3 ? OP_HOUT : q == 4 ? OP_HPROJ : q == 5 ? OP_UP : OP_DOWN; }
}

template <int MASK>
__device__ __forceinline__ void run_op(const Params& p, int op, int L, int wid_s) {
    unsigned char* ws = p.ws;
    float* xf = p.out + O_Y; bf16_t* xb = (bf16_t*)(ws + WS_XB); float* ssq = (float*)(ws + WS_SSQP);
#define PHON(x) if (!((MASK >> (x)) & 1)) break;
    switch (op) {
    case OP_PREP: PHON(OP_PREP) phase_prep(p, wid_s); break;
    case OP_POOLD: PHON(OP_POOLD) phase_pool_d(p, L, wid_s); break;
    case OP_HDS: PHON(OP_HDS) phase_hds(p, wid_s); break;
    case OP_HSCAN: PHON(OP_HSCAN) phase_hscan(p, L, wid_s); break;
    case OP_HOUT: PHON(OP_HOUT) phase_hout(p, L, wid_s); break;
    case OP_FINAL: PHON(OP_FINAL) phase_final(p, wid_s); break;
    case OP_POOLG: case OP_HPROJ: case OP_DOWN: { PHON(OP_DOWN)
        GemmArgs g; EpiResid e; e.xf = xf; e.xb = xb; e.xin_p = xf; e.xin_s = xf + (size_t)MP * DM; e.colscale = nullptr; e.koff_per_pn = 0;
        g.nM = M_TOK / BM; g.nN = DM / BM;
        if (op == OP_POOLG) { g.A = (const bf16_t*)(ws + WS_DBUF); g.lda = DM; g.K = 256; g.Bt = (const bf16_t*)(ws + WS_WPOOL) + (size_t)(L >> 1) * 4 * 65536; g.ldb = 256;
            e.colscale = p.in[I_POOLSC] + (L >> 1) * DM; e.koff_per_pn = 256; e.ssq = ssq + (size_t)(2 * L + 1) * SSQ_STRIDE;
            if (L == 0) { e.xin_p = p.in[I_XP]; e.xin_s = p.in[I_XS]; } }
        else if (op == OP_HPROJ) { g.A = (const bf16_t*)(ws + WS_QB); g.lda = DM; g.K = DM; g.Bt = (const bf16_t*)(ws + WS_WOUT) + (size_t)(L >> 1) * DM * DM; g.ldb = DM; e.ssq = ssq + (size_t)(2 * L + 1) * SSQ_STRIDE; }
        else { g.A = (const bf16_t*)(ws + WS_HID); g.lda = FF; g.K = FF; g.Bt = (const bf16_t*)(ws + WS_WDN) + (size_t)L * DM * FF; g.ldb = FF; e.ssq = ssq + (size_t)(2 * L + 2) * SSQ_STRIDE; }
        gemm_phase(g, e, wid_s);
    } break;
    case OP_HIN: { PHON(OP_HIN)
        GemmArgs g; g.A = xb; g.lda = DM; g.K = DM; g.Bt = (const bf16_t*)(ws + WS_WIN) + (size_t)(L >> 1) * 4 * DM * DM; g.ldb = DM; g.nM = M_TOK / BM; g.nN = 4 * DM / BM;
        EpiHin e; e.ssq = ssq + (size_t)(2 * L) * SSQ_STRIDE; e.lb = (const float*)(ws + WS_LB) + L * DM; e.ws = ws;
        gemm_phase(g, e, wid_s);
    } break;
    case OP_UP: { PHON(OP_UP)
        GemmArgs g; g.A = xb; g.lda = DM; g.K = DM; g.Bt = (const bf16_t*)(ws + WS_WUP) + (size_t)L * 2 * FF * DM; g.ldb = DM; g.nM = 136; g.nN = 2 * FF / BM;
        EpiUp e; e.ssq = ssq + (size_t)(2 * L + 1) * SSQ_STRIDE; e.cw = p.in[I_CONVW] + (size_t)L * 3 * FF; e.cb = p.in[I_CONVB] + (size_t)L * FF; e.hist = p.in[I_SCONV] + (size_t)L * 16 * 2 * FF;
        e.hid = (bf16_t*)(ws + WS_HID); e.cvp = p.out + O_CVP + (size_t)L * 4 * 2 * FF; e.cvs = p.out + O_CVS + (size_t)L * 16 * 2 * FF;
        gemm_phase(g, e, wid_s);
    } break;
    }
#undef PHON
}

__global__ void __launch_bounds__(512, 2) mega(Params p, int ph_lo, int ph_hi) {
    const int wid_s = __builtin_amdgcn_readfirstlane((int)(threadIdx.x >> 6));
    for (int ph = ph_lo; ph < ph_hi; ++ph) {
        int op, L; phase_decode(ph, op, L);
        switch (op) {
        case OP_PREP: run_op<1 << OP_PREP>(p, OP_PREP, L, wid_s); break;
        case OP_POOLD: run_op<1 << OP_POOLD>(p, OP_POOLD, L, wid_s); break;
        case OP_POOLG: run_op<1 << OP_DOWN>(p, OP_POOLG, L, wid_s); break;
        case OP_HIN: run_op<1 << OP_HIN>(p, OP_HIN, L, wid_s); break;
        case OP_HDS: run_op<1 << OP_HDS>(p, OP_HDS, L, wid_s); break;
        case OP_HSCAN: run_op<1 << OP_HSCAN>(p, OP_HSCAN, L, wid_s); break;
        case OP_HOUT: run_op<1 << OP_HOUT>(p, OP_HOUT, L, wid_s); break;
        case OP_HPROJ: run_op<1 << OP_DOWN>(p, OP_HPROJ, L, wid_s); break;
        case OP_UP: run_op<1 << OP_UP>(p, OP_UP, L, wid_s); break;
        case OP_DOWN: run_op<1 << OP_DOWN>(p, OP_DOWN, L, wid_s); break;
        default: run_op<1 << OP_FINAL>(p, OP_FINAL, L, wid_s); break;
        }
        if (ph + 1 < ph_hi) cg::this_grid().sync();
    }
}
template <int OP>
__global__ void __launch_bounds__(512, 2) phase_kernel(Params p, int L) {
    const int wid_s = __builtin_amdgcn_readfirstlane((int)(threadIdx.x >> 6));
    constexpr int MASK = (OP == OP_POOLG || OP == OP_HPROJ) ? (1 << OP_DOWN) : (1 << OP);
    run_op<MASK>(p, OP, L, wid_s);
}
template <int OP> static void launch_phase(const Params& p, int L, int grid, hipStream_t stream) {
    static bool attr = false;
    if (!attr) { (void)hipFuncSetAttribute((const void*)phase_kernel<OP>, hipFuncAttributeMaxDynamicSharedMemorySize, LDS_BYTES); attr = true; }
    hipLaunchKernelGGL(phase_kernel<OP>, dim3(grid), dim3(512), LDS_BYTES, stream, p, L);
}

extern "C" void kernel_launch(void* const* d_in, const int* in_sizes, int n_in, void* d_out, int out_size, void* d_ws, size_t ws_size, hipStream_t stream) {
    static int grid_blocks = 0;
    if (!grid_blocks) {
        hipFuncSetAttribute((const void*)mega, hipFuncAttributeMaxDynamicSharedMemorySize, LDS_BYTES);
        int dev = 0, cus = 0, per_cu = 0; hipGetDevice(&dev);
        hipDeviceGetAttribute(&cus, hipDeviceAttributeMultiprocessorCount, dev);
        hipOccupancyMaxActiveBlocksPerMultiprocessor(&per_cu, mega, 512, LDS_BYTES);
        if (per_cu < 1) per_cu = 1;
        grid_blocks = cus * 1;
        if (ws_size < WS_NEED) fprintf(stderr, "workspace too small: %zu < %zu\n", ws_size, (size_t)WS_NEED);
    }
    if (ws_size < WS_NEED || n_in != 18) return;
    Params p{};
    for (int i = 0; i < 18; ++i) p.in[i] = (const float*)d_in[i];
    p.out = (float*)d_out; p.ws = (unsigned char*)d_ws;
#if defined(BISECT_N)
    for (int ph = 0; ph < BISECT_N; ++ph) hipLaunchKernelGGL(mega, dim3(grid_blocks), dim3(512), LDS_BYTES, stream, p, ph, ph + 1);
#elif MK_SINGLE
    int lo = 0, hi = NPH; void* args[] = {&p, &lo, &hi};
    hipError_t e = hipLaunchCooperativeKernel((const void*)mega, dim3(grid_blocks), dim3(512), args, LDS_BYTES, stream);
    if (e != hipSuccess) fprintf(stderr, "cooperative launch failed: %s (grid %d)\n", hipGetErrorString(e), grid_blocks);
#else
    for (int ph = 0; ph < NPH; ++ph) {
        int op, L;
        if (ph == 0) { op = OP_PREP; L = 0; } else if (ph == 23) { op = OP_FINAL; L = 0; }
        else { int q = ph - 1; const int pr = q / 11; q %= 11;
            if (q < 4) { L = 2 * pr; op = q == 0 ? OP_POOLD : q == 1 ? OP_POOLG : q == 2 ? OP_UP : OP_DOWN; }
            else { q -= 4; L = 2 * pr + 1; op = q == 0 ? OP_HIN : q == 1 ? OP_HDS : q == 2 ? OP_HSCAN : q == 3 ? OP_HOUT : q == 4 ? OP_HPROJ : q == 5 ? OP_UP : OP_DOWN; } }
        switch (op) {
        case OP_PREP: launch_phase<OP_PREP>(p, L, grid_blocks, stream); break;
        case OP_POOLD: launch_phase<OP_POOLD>(p, L, grid_blocks, stream); break;
        case OP_POOLG: launch_phase<OP_POOLG>(p, L, grid_blocks, stream); break;
        case OP_HIN: launch_phase<OP_HIN>(p, L, grid_blocks, stream); break;
        case OP_HDS: launch_phase<OP_HDS>(p, L, grid_blocks, stream); break;
        case OP_HSCAN: launch_phase<OP_HSCAN>(p, L, grid_blocks, stream); break;
        case OP_HOUT: launch_phase<OP_HOUT>(p, L, grid_blocks, stream); break;
        case OP_HPROJ: launch_phase<OP_HPROJ>(p, L, grid_blocks, stream); break;
        case OP_UP: launch_phase<OP_UP>(p, L, grid_blocks, stream); break;
        case OP_DOWN: launch_phase<OP_DOWN>(p, L, grid_blocks, stream); break;
        default: launch_phase<OP_FINAL>(p, L, grid_blocks, stream); break;
        }
    }
#endif
}
```

```cpp
#include <hip/hip_runtime.h>
#include <hip/hip_cooperative_groups.h>
#include <cstdint>
#include <cstdio>
namespace cg = cooperative_groups;


#ifndef MK_SINGLE
#define MK_SINGLE 1
#endif

typedef unsigned short bf16_t;
typedef short bf16x8 __attribute__((ext_vector_type(8)));
typedef float f32x4 __attribute__((ext_vector_type(4)));
typedef float f32x2 __attribute__((ext_vector_type(2)));
typedef unsigned u32x4 __attribute__((ext_vector_type(4)));
typedef unsigned u32x2 __attribute__((ext_vector_type(2)));
typedef _Float16 h16x4 __attribute__((ext_vector_type(4)));

constexpr int M_TOK = 33792, MP = 32768, DM = 1024, FF = 2816, SEQ = 8192, DSEQ = 64;
constexpr float EPS = 1e-6f;
constexpr int BM = 256, BK = 64, HALF = 128, HT = HALF * BK, NXCD = 8, WGM = 8;
constexpr int LDS_RS = 256 * 528;
constexpr int LDS_BYTES = 256 * 528 + 1024;

constexpr size_t MiB = (size_t)1 << 20;
constexpr size_t WS_SSQ = 0;
constexpr size_t WS_LB = 2 * MiB;
constexpr size_t WS_DC = 3 * MiB;
constexpr size_t WS_W = 8 * MiB;
constexpr size_t WS_WUP = WS_W, WS_WDN = WS_W + 44 * MiB, WS_WIN = WS_W + 66 * MiB, WS_WOUT = WS_W + 82 * MiB, WS_WPOOL = WS_W + 86 * MiB;
constexpr size_t WS_XB = 96 * MiB;
constexpr size_t WS_SCR = 162 * MiB;
constexpr size_t WS_HID = WS_SCR, WS_DBUF = WS_SCR, WS_DS = WS_XB  ;
constexpr size_t WS_LF = WS_SCR + 66 * MiB, WS_QB = WS_SCR + 132 * MiB, WS_VB = WS_SCR + 198 * MiB, WS_GB = WS_SCR + 264 * MiB;
constexpr size_t WS_SSQP = WS_SCR + 330 * MiB;
constexpr size_t SSQ_STRIDE = (size_t)M_TOK * 16;
constexpr size_t WS_NEED = WS_SSQP + 9 * SSQ_STRIDE * 4;

constexpr size_t O_Y = 0, O_POOLP = 34603008, O_POOLS = 34725888, O_HGP = 35217408, O_HGS = 36265984, O_CVP = 40460288, O_CVS = 40550400;

struct Params { const float* in[18]; float* out; unsigned char* ws; };
enum { I_XP = 0, I_XS, I_SPOOL, I_SHG, I_SCONV, I_NMIXG, I_POOLW, I_POOLSC, I_HWIN, I_LBLOG, I_HNORMG, I_HWOUT, I_NFFNG, I_WUP, I_CONVW, I_CONVB, I_WDN, I_NOUTG };

extern __shared__ __attribute__((aligned(16))) unsigned char smem[];

typedef __bf16 bf16x2_t __attribute__((ext_vector_type(2)));
__device__ __forceinline__ unsigned cvt_pk_bf16(float lo, float hi) { const f32x2 v = {lo, hi}; const bf16x2_t b = __builtin_convertvector(v, bf16x2_t); return __builtin_bit_cast(unsigned, b); }
__device__ __forceinline__ float bf_lo(unsigned w) { return __uint_as_float(w << 16); }
__device__ __forceinline__ float bf_hi(unsigned w) { return __uint_as_float(w & 0xffff0000u); }
__device__ __forceinline__ float fexp(float x) { return __builtin_amdgcn_exp2f(x * 1.4426950408889634f); }
__device__ __forceinline__ float flog(float x) { return __builtin_amdgcn_logf(x) * 0.6931471805599453f; }
__device__ __forceinline__ float sigmoidf_(float z) { return __builtin_amdgcn_rcpf(1.0f + __builtin_amdgcn_exp2f(z * -1.4426950408889634f)); }
__device__ __forceinline__ float rstd_of(float ssq) { return rsqrtf(ssq * (1.0f / 1024.0f) + EPS); }
__device__ __forceinline__ float rstd_row(const float* sp) { const f32x4 a = *(const f32x4*)sp, b = *(const f32x4*)(sp + 4), c = *(const f32x4*)(sp + 8), d = *(const f32x4*)(sp + 12);
    const f32x4 t = (a + b) + (c + d); return rstd_of((t[0] + t[1]) + (t[2] + t[3])); }

__device__ __forceinline__ const char* uniform_ptr(const void* p) { const unsigned long long v = (unsigned long long)p; const unsigned lo = __builtin_amdgcn_readfirstlane((unsigned)v), hi = __builtin_amdgcn_readfirstlane((unsigned)(v >> 32)); return (const char*)(((unsigned long long)hi << 32) | lo); }
template <int NOP>
__device__ __forceinline__ void glds16(const char* sbase, unsigned voff, unsigned lds_addr) {
    if (NOP) asm volatile("s_mov_b32 m0, %2\n\ts_nop 4\n\tglobal_load_lds_dwordx4 %0, %1" :: "v"(voff), "s"(sbase), "s"(lds_addr) : "memory", "m0");
    else asm volatile("s_mov_b32 m0, %2\n\ts_nop 0\n\tglobal_load_lds_dwordx4 %0, %1" :: "v"(voff), "s"(sbase), "s"(lds_addr) : "memory", "m0");
}
__device__ __forceinline__ int tid_launder(int wid_s) { int l; asm volatile("v_mbcnt_lo_u32_b32 %0, -1, 0\n\tv_mbcnt_hi_u32_b32 %0, -1, %0" : "=v"(l)); return wid_s * 64 + l; }

__device__ __forceinline__ int lds_byte(int r, int c) { int st = (r >> 4) * 2 + (c >> 5), rr = r & 15, cc = c & 31, ob = rr * 64 + cc * 2; return st * 1024 + (ob ^ (((ob >> 9) & 1) << 5)); }
__device__ __forceinline__ void stage_rc(int b, int& R, int& C) { int st = b / 1024, sb = b % 1024, swz = sb ^ (((sb >> 9) & 1) << 5); R = (st >> 1) * 16 + swz / 64; C = (st & 1) * 32 + (swz % 64) / 2; }

struct Unit { int pm, pn, kh; };
__device__ __forceinline__ bool unit_next(int i, int nM, int nN, Unit& u) {
    const int nwg = nM * nN; const long L = (long)i * gridDim.x + blockIdx.x; if (L >= nwg) return false;
    int wgid = (int)L; { const int q = nwg / NXCD, r = nwg % NXCD, xcd = wgid % NXCD, off = wgid / NXCD; wgid = (xcd < r ? xcd * (q + 1) : r * (q + 1) + (xcd - r) * q) + off; }
    const int nig = WGM * nN, gid = wgid / nig, fm = gid * WGM, gsz = (nM - fm) < WGM ? (nM - fm) : WGM;
    u.pm = fm + ((wgid % nig) % gsz); u.pn = (wgid % nig) / gsz; u.kh = -1; return true;
}

struct GemmArgs { const bf16_t* A; const bf16_t* Bt; int lda, ldb, K, nM, nN; };

#define LAS __attribute__((address_space(3)))
template <class Epi>
__device__ __forceinline__ void gemm_phase(const GemmArgs g, const Epi& E, int wid_s, unsigned long long* tk = nullptr) {
    LAS unsigned char* lds = (LAS unsigned char*)smem;
    constexpr int HTB = HT * 2;
#define SA(b, h) (((b) * 2 + (h)) * HTB)
#define SB(b, h) ((4 + (b) * 2 + (h)) * HTB)
#define STAGE(bufoff, gbase, voff) do { _Pragma("unroll") for (int _i = 0; _i < 2; ++_i) glds16<0>((gbase), (voff)[_i], ldsb + (unsigned)((bufoff) + _i * 8192)); } while (0)
#define STAGE0(bufoff, gbase, voff) do { _Pragma("unroll") for (int _i = 0; _i < 2; ++_i) glds16<1>((gbase), (voff)[_i], ldsb + (unsigned)((bufoff) + _i * 8192)); } while (0)
#define LDA(dst, b, h) do { _Pragma("unroll") for (int m = 0; m < 4; ++m) _Pragma("unroll") for (int k = 0; k < 2; ++k) dst[m][k] = *(const LAS bf16x8*)(lds + SA(b, h) + aoff + m * 2048 + k * 1024); } while (0)
#define LDB(dst, b, h) do { _Pragma("unroll") for (int n = 0; n < 2; ++n) _Pragma("unroll") for (int k = 0; k < 2; ++k) dst[n][k] = *(const LAS bf16x8*)(lds + SB(b, h) + boff + n * 2048 + k * 1024); } while (0)
#define MMA(ai, bj, At_, Bt_) do { __builtin_amdgcn_s_setprio(1); _Pragma("unroll") for (int m = 0; m < 4; ++m) _Pragma("unroll") for (int n = 0; n < 2; ++n) _Pragma("unroll") for (int k = 0; k < 2; ++k) \
      acc[ai][bj][m][n] = __builtin_amdgcn_mfma_f32_16x16x32_bf16(Bt_[n][k], At_[m][k], acc[ai][bj][m][n], 0, 0, 0); \
    __builtin_amdgcn_s_setprio(0); } while (0)
#define WAIT_V(n) asm volatile("s_waitcnt vmcnt(" #n ")" ::: "memory")
#define WAIT_L(n) asm volatile("s_waitcnt lgkmcnt(" #n ")" ::: "memory")
#define BAR __builtin_amdgcn_s_barrier()
#define SCHED __builtin_amdgcn_sched_barrier(0)
    const int tid = tid_launder(wid_s), wid = __builtin_amdgcn_readfirstlane(tid >> 6), lane = tid & 63, wr = wid >> 2, wc = wid & 3, fr = lane & 15, fq = lane >> 4;
    const int nt_full = g.K / BK;
    unsigned voffA[2], voffB[2];
#pragma unroll
    for (int i = 0; i < 2; ++i) { int R, C; stage_rc(tid * 16 + i * 8192, R, C); const int rho = R & 31, Rb = (R & ~31) + 8 * ((rho & 15) >> 2) + 4 * (rho >> 4) + (rho & 3);
        voffA[i] = (unsigned)(R * g.lda + C) * 2u; voffB[i] = (unsigned)(Rb * g.ldb + C) * 2u; }
    const size_t kstep = (size_t)(BK * 2), hstepA = (size_t)HALF * g.lda * 2, hstepB = (size_t)HALF * g.ldb * 2;
    const unsigned ldsb = (unsigned)__builtin_amdgcn_readfirstlane((int)(unsigned)(unsigned long long)(LAS unsigned char*)smem) + (unsigned)wid * 1024u;
    const int aoff = lds_byte(wr * 64 + fr, fq * 8), boff = lds_byte(wc * 32 + fr, fq * 8);
    Unit u;
    for (int it = 0; E.next(it, g.nM, g.nN, u); ++it) {
        const int nt = u.kh < 0 ? nt_full : nt_full / 2, kh0 = u.kh > 0 ? (nt_full / 2) * BK : 0;
        const char* cA = uniform_ptr(g.A + E.a_row0(u) * (long)g.lda + E.a_koff(u) + kh0);
        const char* cB = uniform_ptr(g.Bt + (long)u.pn * BM * g.ldb + kh0);
        f32x4 acc[2][2][4][2];
#pragma unroll
        for (int a = 0; a < 2; ++a)
#pragma unroll
            for (int b = 0; b < 2; ++b)
#pragma unroll
                for (int m = 0; m < 4; ++m)
#pragma unroll
                    for (int n = 0; n < 2; ++n) acc[a][b][m][n] = (f32x4){0.f, 0.f, 0.f, 0.f};
        bf16x8 At[4][2], B0[2][2], B1[2][2];
#ifdef REPORT_KLOOP
        const unsigned long long tk0 = __builtin_amdgcn_s_memrealtime();
#endif
        STAGE0(SB(0, 0), cB, voffB); STAGE0(SA(0, 0), cA, voffA); STAGE0(SB(0, 1), cB + hstepB, voffB); STAGE0(SA(0, 1), cA + hstepA, voffA);
        if (wr == 1) BAR;
        WAIT_V(4); BAR;
        STAGE0(SB(1, 0), cB + kstep, voffB); STAGE0(SA(1, 0), cA + kstep, voffA); STAGE0(SB(1, 1), cB + hstepB + kstep, voffB);
        WAIT_V(6); BAR;
        for (int t = 0; t < nt - 2; t += 2) {
            const char* a1 = cA + (size_t)(t + 1) * kstep; const char* a2 = cA + (size_t)(t + 2) * kstep; const char* b2 = cB + (size_t)(t + 2) * kstep;
            const char* a3 = a2 + kstep; const char* b3 = b2 + kstep;
            LDB(B0, 0, 0); SCHED; LDA(At, 0, 0); STAGE(SA(1, 1), a1 + hstepA, voffA);
            WAIT_L(8); BAR; WAIT_L(0); MMA(0, 0, At, B0); BAR; SCHED;
            LDB(B1, 0, 1); STAGE(SB(0, 0), b2, voffB);
            BAR; WAIT_L(0); MMA(0, 1, At, B1); BAR;
            LDA(At, 0, 1); STAGE(SA(0, 0), a2, voffA);
            BAR; WAIT_L(0); MMA(1, 0, At, B0); BAR; SCHED;
            STAGE(SB(0, 1), b2 + hstepB, voffB);
            WAIT_V(6); BAR; MMA(1, 1, At, B1); BAR;
            LDB(B0, 1, 0); SCHED; LDA(At, 1, 0); STAGE(SA(0, 1), a2 + hstepA, voffA);
            WAIT_L(8); BAR; WAIT_L(0); MMA(0, 0, At, B0); BAR; SCHED;
            LDB(B1, 1, 1); STAGE(SB(1, 0), b3, voffB);
            BAR; WAIT_L(0); MMA(0, 1, At, B1); BAR;
            LDA(At, 1, 1); STAGE(SA(1, 0), a3, voffA);
            BAR; WAIT_L(0); MMA(1, 0, At, B0); BAR; SCHED;
            STAGE(SB(1, 1), b3 + hstepB, voffB);
            WAIT_V(6); BAR; MMA(1, 1, At, B1); BAR;
        }
        { LDB(B0, 0, 0); LDA(At, 0, 0); STAGE0(SA(1, 1), cA + (size_t)(nt - 1) * kstep + hstepA, voffA);
          BAR; WAIT_L(0); MMA(0, 0, At, B0); BAR;
          LDB(B1, 0, 1); BAR; WAIT_L(0); MMA(0, 1, At, B1); BAR;
          LDA(At, 0, 1); WAIT_V(4); BAR; WAIT_L(0); MMA(1, 0, At, B0); MMA(1, 1, At, B1); BAR; }
        { LDB(B0, 1, 0); LDA(At, 1, 0); WAIT_V(2); BAR; WAIT_L(0); MMA(0, 0, At, B0); BAR;
          LDB(B1, 1, 1); WAIT_V(0); BAR; WAIT_L(0); MMA(0, 1, At, B1); BAR;
          LDA(At, 1, 1); BAR; WAIT_L(0); MMA(1, 0, At, B0); MMA(1, 1, At, B1); BAR; }
        if (wr == 0) BAR;
#ifdef REPORT_KLOOP
        if (tk) *tk += __builtin_amdgcn_s_memrealtime() - tk0;
#endif
        { int l2_; asm volatile("v_mbcnt_lo_u32_b32 %0, -1, 0\n\tv_mbcnt_hi_u32_b32 %0, -1, %0" : "=v"(l2_)); const int fr_ = l2_ & 15, fq_ = l2_ >> 4;
          E(acc, u, wr, wc, fr_, fq_); }
        asm volatile("s_waitcnt vmcnt(0) lgkmcnt(0)" ::: "memory");
        __syncthreads();
    }
}

__device__ __forceinline__ f32x4 ldg4(const bf16_t* p) { const u32x2 w = *(const u32x2*)p; return (f32x4){bf_lo(w.x), bf_hi(w.x), bf_lo(w.y), bf_hi(w.y)}; }
struct EpiResid {
    const float* xin_p; const float* xin_s; float* xf; bf16_t* xb; float* ssq; const float* colscale; int koff_per_pn;
    unsigned* flags;
    __device__ __forceinline__ bool next(int it, int nM, int nN, Unit& u) const {
        if (!flags) return unit_next(it, nM, nN, u);
        const int L = it * (int)gridDim.x + (int)blockIdx.x;
        if (L < 512) return unit_next(it, 128, 4, u);
        const int s = L - 512; if (s >= 32) return false;
        u.pm = 128 + (s >> 3); u.pn = (s >> 1) & 3; u.kh = s & 1; return true;
    }
    __device__ __forceinline__ long a_row0(const Unit& u) const { return (long)u.pm * BM; }
    __device__ __forceinline__ int a_koff(const Unit& u) const { return u.pn * koff_per_pn; }
    __device__ __forceinline__ void operator()(f32x4 (&acc)[2][2][4][2], const Unit& u, int wr, int wc, int fr, int fq) const {
        unsigned* flag = flags ? flags + ((u.pm - 128) * 4 + u.pn) : nullptr;
        if (u.kh == 1) {
            if (wr == 0 && wc == 0) {
                while (__hip_atomic_load(flag, __ATOMIC_RELAXED, __HIP_MEMORY_SCOPE_AGENT) == 0u) __builtin_amdgcn_s_sleep(2);
                __builtin_amdgcn_fence(__ATOMIC_ACQUIRE, "agent");
                asm volatile("s_waitcnt vmcnt(0)" ::: "memory");
            }
            __syncthreads();
        }
        const bool part = u.kh == 0;
        f32x4 csv[2][2];
#pragma unroll
        for (int bj = 0; bj < 2; ++bj)
#pragma unroll
            for (int n = 0; n < 2; ++n) csv[bj][n] = colscale ? *(const f32x4*)(colscale + u.pn * BM + bj * HALF + wc * 32 + fq * 8 + 4 * n) : (f32x4){1.f, 1.f, 1.f, 1.f};
#pragma unroll
        for (int ai = 0; ai < 2; ++ai)
#pragma unroll
            for (int m = 0; m < 4; ++m) {
                const int row = u.pm * BM + ai * HALF + wr * 64 + m * 16 + fr;
                const float* xr = xin_p ? (row < MP ? xin_p + (size_t)row * DM : xin_s + (size_t)(row - MP) * DM) : xf + (size_t)row * DM;
                const bool from_bf = !xin_p && u.kh != 1;
                float ss = 0.f;
#pragma unroll
                for (int bj = 0; bj < 2; ++bj) {
                    const int col = u.pn * BM + bj * HALF + wc * 32 + fq * 8;
                    f32x4 v0 = acc[ai][bj][m][0], v1 = acc[ai][bj][m][1];
                    if (colscale) { v0 = v0 * csv[bj][0]; v1 = v1 * csv[bj][1]; }
                    if (from_bf) { const u32x4 xw = *(const u32x4*)(xb + (size_t)row * DM + col);
                        v0 = v0 + (f32x4){bf_lo(xw.x), bf_hi(xw.x), bf_lo(xw.y), bf_hi(xw.y)}; v1 = v1 + (f32x4){bf_lo(xw.z), bf_hi(xw.z), bf_lo(xw.w), bf_hi(xw.w)}; }
                    else { v0 = v0 + *(const f32x4*)(xr + col); v1 = v1 + *(const f32x4*)(xr + col + 4); }
                    if (part) { *(f32x4*)(xf + (size_t)row * DM + col) = v0; *(f32x4*)(xf + (size_t)row * DM + col + 4) = v1; }
                    else {
                        u32x4 w; w.x = cvt_pk_bf16(v0[0], v0[1]); w.y = cvt_pk_bf16(v0[2], v0[3]); w.z = cvt_pk_bf16(v1[0], v1[1]); w.w = cvt_pk_bf16(v1[2], v1[3]);
                        *(u32x4*)(xb + (size_t)row * DM + col) = w;
                        ss += ((v0[0] * v0[0] + v0[1] * v0[1]) + (v0[2] * v0[2] + v0[3] * v0[3])) + ((v1[0] * v1[0] + v1[1] * v1[1]) + (v1[2] * v1[2] + v1[3] * v1[3]));
                    }
                }
                ss += __shfl_xor(ss, 16); ss += __shfl_xor(ss, 32);
                if (fq == 0 && !part) ssq[(size_t)row * 16 + u.pn * 4 + wc] = ss;
                asm volatile("" ::: "memory");
            }
        if (part) {
            asm volatile("s_waitcnt vmcnt(0)" ::: "memory");
            __syncthreads();
            if (wr == 0 && wc == 0 && fr == 0 && fq == 0) {
                __builtin_amdgcn_fence(__ATOMIC_RELEASE, "agent");
                asm volatile("s_waitcnt vmcnt(0)" ::: "memory");
                __hip_atomic_store(flag, 1u, __ATOMIC_RELAXED, __HIP_MEMORY_SCOPE_AGENT);
            }
        }
    }
};

struct EpiHin {
    __device__ __forceinline__ bool next(int it, int nM, int nN, Unit& u) const { return unit_next(it, nM, nN, u); }
    const float* ssq; const float* lb; unsigned char* ws;
    __device__ __forceinline__ long a_row0(const Unit& u) const { return (long)u.pm * BM; }
    __device__ __forceinline__ int a_koff(const Unit&) const { return 0; }
    __device__ __forceinline__ void operator()(f32x4 (&acc)[2][2][4][2], const Unit& u, int wr, int wc, int fr, int fq) const {
        const int sec = u.pn >> 2;
        float* rsT = (float*)(smem + LDS_RS);
        { const int t = (wr * 4 + wc) * 64 + fq * 16 + fr; if (t < 256) rsT[t] = rstd_row(ssq + (size_t)(u.pm * BM + t) * 16); }
        f32x4 lbv[2][2];
#pragma unroll
        for (int bj = 0; bj < 2; ++bj)
#pragma unroll
            for (int n = 0; n < 2; ++n) lbv[bj][n] = sec == 1 ? *(const f32x4*)(lb + (u.pn & 3) * BM + bj * HALF + wc * 32 + fq * 8 + 4 * n) : (f32x4){0.f, 0.f, 0.f, 0.f};
        __syncthreads();
#pragma unroll
        for (int ai = 0; ai < 2; ++ai)
#pragma unroll
            for (int m = 0; m < 4; ++m) {
                const int row = u.pm * BM + ai * HALF + wr * 64 + m * 16 + fr;
                const float rs = rsT[ai * HALF + wr * 64 + m * 16 + fr];
#pragma unroll
                for (int bj = 0; bj < 2; ++bj) {
                    const int cs = (u.pn & 3) * BM + bj * HALF + wc * 32 + fq * 8;
                    const size_t o = (size_t)row * DM + cs;
                    u32x4 w;
#pragma unroll
                    for (int n = 0; n < 2; ++n) {
                        const f32x4 z = acc[ai][bj][m][n] * rs; unsigned p0, p1;
                        if (sec == 1) {
                            const f32x4 l4 = lbv[bj][n]; h16x4 h;
#pragma unroll
                            for (int j = 0; j < 4; ++j) { const float f = l4[j] + (1.0f - l4[j]) * sigmoidf_(z[j]); h[j] = (_Float16)flog(f); }
                            const u32x2 hw = __builtin_bit_cast(u32x2, h); p0 = hw.x; p1 = hw.y;
                        } else {
                            f32x4 r = z;
                            if (sec != 2) {
#pragma unroll
                                for (int j = 0; j < 4; ++j) r[j] = z[j] * sigmoidf_(z[j]);
                            }
                            p0 = cvt_pk_bf16(r[0], r[1]); p1 = cvt_pk_bf16(r[2], r[3]);
                        }
                        if (n == 0) { w.x = p0; w.y = p1; } else { w.z = p0; w.w = p1; }
                    }
                    unsigned char* dst = sec == 1 ? ws + WS_LF : ws + WS_QB + (size_t)(sec == 0 ? 0 : sec - 1) * (66 * MiB);
                    *(u32x4*)(dst + o * 2) = w;
                }
            }
    }
};

struct EpiUp {
    __device__ __forceinline__ bool next(int it, int nM, int nN, Unit& u) const { return unit_next(it, nM, nN, u); }
    const float* ssq; const float* cw; const float* cb; const float* hist; bf16_t* hid; float* cvp; float* cvs;
    __device__ __forceinline__ long a_row0(const Unit& u) const { return u.pm < 132 ? (long)(u.pm / 33) * SEQ + 254 * (u.pm % 33) - 2 : (long)MP + 256 * (u.pm - 132); }
    __device__ __forceinline__ int a_koff(const Unit&) const { return 0; }
    __device__ __forceinline__ void operator()(f32x4 (&acc)[2][2][4][2], const Unit& u, int wr, int wc, int fr, int fq) const {
        float* G = (float*)smem;
        const bool prompt = u.pm < 132; const int tt = u.pm % 33;
        const long rbase = a_row0(u);
        const long row_end = prompt ? (long)(u.pm / 33 + 1) * SEQ : (long)M_TOK;
        const int cl0 = wc * 32 + fq * 8, c0 = u.pn * HALF + cl0;
        f32x4 w0[2], w1[2], w2[2], bb[2];
#pragma unroll
        for (int n = 0; n < 2; ++n) { w0[n] = *(const f32x4*)(cw + c0 + 4 * n); w1[n] = *(const f32x4*)(cw + FF + c0 + 4 * n); w2[n] = *(const f32x4*)(cw + 2 * FF + c0 + 4 * n); bb[n] = *(const f32x4*)(cb + c0 + 4 * n); }
        float* rsT = (float*)(smem + LDS_RS);
        { const int t = (wr * 4 + wc) * 64 + fq * 16 + fr; if (t < 256) { long gr = rbase + t; if (gr < 0) gr = 0; rsT[t] = rstd_row(ssq + (size_t)gr * 16); } }
        __syncthreads();
#pragma unroll
        for (int ai = 0; ai < 2; ++ai)
#pragma unroll
            for (int m = 0; m < 4; ++m) {
                const int lrow = ai * HALF + wr * 64 + m * 16 + fr;
                const float rsv = rsT[lrow];
                const bool zero = prompt && tt == 0 && lrow < 2;
#pragma unroll
                for (int n = 0; n < 2; ++n) {
                    f32x4 gv = acc[ai][0][m][n] * rsv; acc[ai][1][m][n] = acc[ai][1][m][n] * rsv; if (zero) gv = (f32x4){0.f, 0.f, 0.f, 0.f};
                    acc[ai][0][m][n] = gv;
                    *(f32x4*)(G + lrow * 132 + wc * 32 + fq * 8 + n * 4) = gv;
                }
            }
        __syncthreads();
        if (prompt) {
#pragma unroll
            for (int ai = 0; ai < 2; ++ai)
#pragma unroll
                for (int m = 0; m < 4; ++m) {
                    const int lrow = ai * HALF + wr * 64 + m * 16 + fr; const long gr = rbase + lrow;
                    if (lrow >= 2 && gr < row_end) {
                        const float* Gp = G + (lrow - 2) * 132 + cl0; bf16_t* hp = hid + (size_t)gr * FF + c0; u32x4 hw;
#pragma unroll
                        for (int n = 0; n < 2; ++n) {
                            const f32x4 g2 = *(const f32x4*)(Gp + 4 * n), g1 = *(const f32x4*)(Gp + 132 + 4 * n), g0 = acc[ai][0][m][n];
                            const f32x4 cv = bb[n] + w0[n] * g2 + w1[n] * g1 + w2[n] * g0, vv = acc[ai][1][m][n];
                            f32x4 h;
#pragma unroll
                            for (int j = 0; j < 4; ++j) h[j] = cv[j] * sigmoidf_(cv[j]) * vv[j];
                            if (n == 0) { hw.x = cvt_pk_bf16(h[0], h[1]); hw.y = cvt_pk_bf16(h[2], h[3]); } else { hw.z = cvt_pk_bf16(h[0], h[1]); hw.w = cvt_pk_bf16(h[2], h[3]); }
                        }
                        *(u32x4*)hp = hw;
                        const int l = (int)(gr & (SEQ - 1));
                        if (l >= SEQ - 2) {
                            float* cp = cvp + ((size_t)(gr >> 13) * 2 + (l - (SEQ - 2))) * FF + c0;
                            *(f32x4*)cp = acc[ai][0][m][0]; *(f32x4*)(cp + 4) = acc[ai][0][m][1];
                        }
                    }
                    asm volatile("" ::: "memory");
                }
        } else {
#pragma unroll
            for (int ai = 0; ai < 2; ++ai)
#pragma unroll
                for (int m = 0; m < 4; ++m) {
                    const int lrow = ai * HALF + wr * 64 + m * 16 + fr, l = lrow & 63; const long gr = rbase + lrow;
                    const int b = (int)(gr - MP) >> 6; const float* hb = hist + (size_t)b * 2 * FF + c0; bf16_t* hp = hid + (size_t)gr * FF + c0;
#pragma unroll
                    for (int n = 0; n < 2; ++n) {
                        f32x4 g1, g2; const f32x4 g0 = acc[ai][0][m][n];
                        if (l >= 2) { g1 = *(const f32x4*)(G + (lrow - 1) * 132 + cl0 + 4 * n); g2 = *(const f32x4*)(G + (lrow - 2) * 132 + cl0 + 4 * n); }
                        else if (l == 0) { g2 = *(const f32x4*)(hb + 4 * n); g1 = *(const f32x4*)(hb + FF + 4 * n); }
                        else { g2 = *(const f32x4*)(hb + FF + 4 * n); g1 = *(const f32x4*)(G + (lrow - 1) * 132 + cl0 + 4 * n); }
                        const f32x4 cv = bb[n] + w0[n] * g2 + w1[n] * g1 + w2[n] * g0, vv = acc[ai][1][m][n];
                        f32x4 h;
#pragma unroll
                        for (int j = 0; j < 4; ++j) h[j] = cv[j] * sigmoidf_(cv[j]) * vv[j];
                        u32x2 w; w.x = cvt_pk_bf16(h[0], h[1]); w.y = cvt_pk_bf16(h[2], h[3]);
                        *(u32x2*)(hp + 4 * n) = w;
                        if (l >= 62) *(f32x4*)(cvs + ((size_t)b * 2 + (l - 62)) * FF + c0 + 4 * n) = g0;
                    }
                    asm volatile("" ::: "memory");
                }
        }
    }
};


__device__ __forceinline__ void prep_tile(const float* W, int K, int N, const float* gk, bf16_t* Wt, int k0, int n0, int nd0, int wid_s) {
    bf16_t* T = (bf16_t*)smem;
    const int tid = tid_launder(wid_s), ln = tid & 31;
#pragma unroll
    for (int i = 0; i < 8; ++i) {
        const int k = i * 16 + (tid >> 5);
        f32x4 v = *(const f32x4*)(W + (size_t)(k0 + k) * N + n0 + ln * 4);
        if (gk) v = v * gk[k0 + k];
        const unsigned p0 = cvt_pk_bf16(v[0], v[1]), p1 = cvt_pk_bf16(v[2], v[3]);
        T[(0 * 32 + ln) * 130 + k] = (bf16_t)(p0 & 0xffff); T[(1 * 32 + ln) * 130 + k] = (bf16_t)(p0 >> 16);
        T[(2 * 32 + ln) * 130 + k] = (bf16_t)(p1 & 0xffff); T[(3 * 32 + ln) * 130 + k] = (bf16_t)(p1 >> 16);
    }
    __syncthreads();
#pragma unroll
    for (int i = 0; i < 4; ++i) {
        const int n = i * 32 + (tid >> 4), kq = (tid & 15) * 8;
        const unsigned* src = (const unsigned*)(T + ((n & 3) * 32 + (n >> 2)) * 130 + kq);
        u32x4 v; v.x = src[0]; v.y = src[1]; v.z = src[2]; v.w = src[3];
        *(u32x4*)(Wt + (size_t)(nd0 + n) * K + k0 + kq) = v;
    }
    __syncthreads();
}

__device__ __forceinline__ void prep_weights_layer(const Params& p, int L, int first, int stride, int wid_s) {
    unsigned char* ws = p.ws; const int j = L >> 1; const int nt = 528 + ((L & 1) ? 320 : 16);
    for (int t = first; t < nt; t += stride) {
        const float* W; const float* gk = nullptr; bf16_t* Wt; int K, N, lt, mode = 0;
        if (t < 352) { lt = t; K = DM; N = 2 * FF; W = p.in[I_WUP] + (size_t)L * DM * 2 * FF; gk = p.in[I_NFFNG] + L * DM; Wt = (bf16_t*)(ws + WS_WUP) + (size_t)L * 2 * FF * DM; mode = 1; }
        else if (t < 528) { lt = t - 352; K = FF; N = DM; W = p.in[I_WDN] + (size_t)L * FF * DM; Wt = (bf16_t*)(ws + WS_WDN) + (size_t)L * DM * FF; }
        else if (!(L & 1)) { const int mg = j * 4 + (t - 528) / 4; lt = (t - 528) % 4; K = 256; N = 256; W = p.in[I_POOLW] + (size_t)mg * 65536; Wt = (bf16_t*)(ws + WS_WPOOL) + (size_t)mg * 65536; }
        else if (t < 528 + 256) { lt = t - 528; K = DM; N = 4 * DM; W = p.in[I_HWIN] + (size_t)j * DM * 4 * DM; gk = p.in[I_NMIXG] + L * DM; Wt = (bf16_t*)(ws + WS_WIN) + (size_t)j * 4 * DM * DM; }
        else { lt = t - 784; K = DM; N = DM; W = p.in[I_HWOUT] + (size_t)j * DM * DM; Wt = (bf16_t*)(ws + WS_WOUT) + (size_t)j * DM * DM; }
        const int nkb = K / 128, kb = lt % nkb, nb = lt / nkb;
        int nd0 = nb * 128; if (mode == 1) nd0 = nb < 22 ? nb * 256 : (nb - 22) * 256 + 128;
        prep_tile(W, K, N, gk, Wt, kb * 128, nb * 128, nd0, wid_s);
    }
}

__device__ __forceinline__ void phase_prep(const Params& p, int wid_s) {
    unsigned char* ws = p.ws;
    prep_weights_layer(p, 0, blockIdx.x, gridDim.x, wid_s);
    const int tidp = tid_launder(wid_s); const int gtid = blockIdx.x * blockDim.x + tidp, gsz = gridDim.x * blockDim.x;
    for (int c = gtid; c < DM; c += gsz) {
        const float* lg = p.in[I_LBLOG]; float a0 = lg[c], a1 = lg[DM + c], a2 = lg[2 * DM + c], a3 = lg[3 * DM + c];
        const float mx = fmaxf(fmaxf(a0, a1), fmaxf(a2, a3)); a0 = expf(a0 - mx); a1 = expf(a1 - mx); a2 = expf(a2 - mx); a3 = expf(a3 - mx);
        const float inv = 1.0f / (a0 + a1 + a2 + a3); float* lb = (float*)(ws + WS_LB);
        lb[c] = 0.f; lb[DM + c] = a1 * inv; lb[2 * DM + c] = (a1 + a2) * inv; lb[3 * DM + c] = (a1 + a2 + a3) * inv;
    }
    const int wv = gtid >> 6, nwv = gsz >> 6, lane = tidp & 63;
    bf16_t* xb = (bf16_t*)(ws + WS_XB); float* ssq0 = (float*)(ws + WS_SSQP);
    for (int row = wv; row < M_TOK; row += nwv) {
        const float* xr = row < MP ? p.in[I_XP] + (size_t)row * DM : p.in[I_XS] + (size_t)(row - MP) * DM;
        float ss = 0.f;
#pragma unroll
        for (int i = 0; i < 4; ++i) {
            const f32x4 v = *(const f32x4*)(xr + i * 256 + lane * 4);
            ss += (v[0] * v[0] + v[1] * v[1]) + (v[2] * v[2] + v[3] * v[3]);
            u32x2 w; w.x = cvt_pk_bf16(v[0], v[1]); w.y = cvt_pk_bf16(v[2], v[3]);
            *(u32x2*)(xb + (size_t)row * DM + i * 256 + lane * 4) = w;
        }
#pragma unroll
        for (int o = 32; o >= 1; o >>= 1) ss += __shfl_xor(ss, o);
        if (lane < 16) ssq0[(size_t)row * 16 + lane] = lane == 0 ? ss : 0.f;
    }
}

template <int WIN>
__device__ __forceinline__ void pool_walk(const Params& p, int L, int sgi, const float* rsT, int tid) {
    const int  c0 = tid * 2, j = L >> 1;
    const int R0 = sgi * 64; const bool prompt = R0 < MP;
    const int b = prompt ? R0 >> 13 : (R0 - MP) >> 6, l0 = prompt ? (R0 & (SEQ - 1)) : 0, Lseq = prompt ? SEQ : DSEQ;
    const bf16_t* xb = (const bf16_t*)(p.ws + WS_XB); bf16_t* dbuf = (bf16_t*)(p.ws + WS_DBUF);
    const f32x2 g2 = *(const f32x2*)(p.in[I_NMIXG] + L * DM + c0);
    const float* hist = p.in[I_SPOOL] + ((size_t)j * 16 + b) * 15 * DM + c0;
    float* outp = prompt ? p.out + O_POOLP + ((size_t)j * 4 + b) * 15 * DM + c0 : p.out + O_POOLS + ((size_t)j * 16 + b) * 15 * DM + c0;
    unsigned raw[79]; f32x2 hv[15];
    const bool warm = l0 >= 15;
    const bf16_t* xp = xb + (size_t)(R0 - 15) * DM + c0;
#pragma unroll
    for (int i = 15; i < 79; ++i) raw[i] = *(const unsigned*)(xp + (size_t)i * DM);
    if (warm) {
#pragma unroll
        for (int i = 0; i < 15; ++i) raw[i] = *(const unsigned*)(xp + (size_t)i * DM);
    } else {
#pragma unroll
        for (int i = 0; i < 15; ++i) raw[i] = 0u;
    }
    if (!prompt) {
#pragma unroll
        for (int i = 0; i < 15; ++i) hv[i] = *(const f32x2*)(hist + (size_t)i * DM);
    } else {
#pragma unroll
        for (int i = 0; i < 15; ++i) hv[i] = (f32x2){0.f, 0.f};
    }
    float r0[16], r1[16]; float s0 = 0.f, s1 = 0.f;
#pragma unroll
    for (int k = 0; k < 16; ++k) { r0[k] = 0.f; r1[k] = 0.f; }
#pragma unroll
    for (int i = 0; i < 79; ++i) {
        const int k = i & 15, li = l0 - 15 + i;
        float h0, h1;
        if (i >= 15 || warm) { const float rs = rsT[i]; h0 = bf_lo(raw[i]) * rs * g2.x; h1 = bf_hi(raw[i]) * rs * g2.y; }
        else { h0 = hv[i < 15 ? i : 0].x; h1 = hv[i < 15 ? i : 0].y; }
        s0 += h0 - r0[(k - WIN) & 15]; s1 += h1 - r1[(k - WIN) & 15];
        r0[k] = h0; r1[k] = h1;
        if (i >= 15) {
            const int cnt = prompt ? (li + 1 < WIN ? li + 1 : WIN) : WIN; const float inv = 1.0f / (float)cnt;
            *(unsigned*)(dbuf + (size_t)(R0 + i - 15) * DM + c0) = cvt_pk_bf16(s0 * inv - h0, s1 * inv - h1);
            if (li >= Lseq - 15) *(f32x2*)(outp + (size_t)(li - (Lseq - 15)) * DM) = (f32x2){h0, h1};
        }
    }
}
__device__ __forceinline__ void phase_pool_d(const Params& p, int L, int wid_s) {
    float* rsT = (float*)smem; const float* ssq = (const float*)(p.ws + WS_SSQP) + (size_t)(2 * L) * SSQ_STRIDE;
    const int tid = tid_launder(wid_s);
    for (int sgi = blockIdx.x; sgi < M_TOK / 64; sgi += gridDim.x) {
        const int R0 = sgi * 64;
        __syncthreads();
        if (tid < 79) { const int r = R0 - 15 + tid; rsT[tid] = rstd_row(ssq + (size_t)(r < 0 ? 0 : r) * 16); }
        __syncthreads();
        switch (tid >> 7) { case 0: pool_walk<2>(p, L, sgi, rsT, tid); break; case 1: pool_walk<4>(p, L, sgi, rsT, tid); break; case 2: pool_walk<8>(p, L, sgi, rsT, tid); break; default: pool_walk<16>(p, L, sgi, rsT, tid); break; }
    }
}

struct ChunkB { float lf[4][4]; float b[4][4]; float bref[4]; float bC[4]; };
__device__ __forceinline__ void lds_barrier() { asm volatile("s_waitcnt lgkmcnt(0)" ::: "memory"); __builtin_amdgcn_s_barrier(); asm volatile("" ::: "memory"); }
struct ChunkRaw { u32x2 lf[4]; };
__device__ __forceinline__ void chunk_load_lf(const _Float16* lfp, ChunkRaw& r, int tid) {
    const int cg = tid & 31, rg = tid >> 5;
#pragma unroll
    for (int i = 0; i < 4; ++i) r.lf[i] = *(const u32x2*)(lfp + (size_t)(4 * rg + i) * DM + 4 * cg);
}
__device__ __forceinline__ void chunk_cumsum(const ChunkRaw& r, ChunkB& cb, float* T  , int tid) {
    const int cg = tid & 31, rg = tid >> 5;
#pragma unroll
    for (int i = 0; i < 4; ++i) { const h16x4 h = __builtin_bit_cast(h16x4, r.lf[i]);
#pragma unroll
        for (int j = 0; j < 4; ++j) cb.lf[i][j] = (float)h[j]; }
#pragma unroll
    for (int j = 0; j < 4; ++j) { cb.b[0][j] = cb.lf[0][j]; cb.b[1][j] = cb.b[0][j] + cb.lf[1][j]; cb.b[2][j] = cb.b[1][j] + cb.lf[2][j]; cb.b[3][j] = cb.b[2][j] + cb.lf[3][j]; }
    *(f32x4*)(T + rg * 128 + 4 * cg) = (f32x4){cb.b[3][0], cb.b[3][1], cb.b[3][2], cb.b[3][3]};
    lds_barrier();
    f32x4 off = {0.f, 0.f, 0.f, 0.f}, br = {0.f, 0.f, 0.f, 0.f}, bc = {0.f, 0.f, 0.f, 0.f};
#pragma unroll
    for (int r2 = 0; r2 < 16; ++r2) { const f32x4 t = *(const f32x4*)(T + r2 * 128 + 4 * cg); if (r2 < rg) off = off + t; if (r2 < 8) br = br + t; bc = bc + t; }
#pragma unroll
    for (int j = 0; j < 4; ++j) { cb.bref[j] = br[j]; cb.bC[j] = bc[j];
#pragma unroll
        for (int i = 0; i < 4; ++i) cb.b[i][j] += off[j]; }
}

__device__ __forceinline__ void phase_hds(const Params& p, int wid_s) {
    unsigned char* ws = p.ws;
    float* T = (float*)smem;
    unsigned char* KdT = smem + 8192;
    unsigned char* Vt = KdT + 128 * 144;
    const _Float16* lf = (const _Float16*)(ws + WS_LF); const bf16_t* vb = (const bf16_t*)(ws + WS_VB);
    bf16_t* dS = (bf16_t*)(p.out + O_Y); float* dc = (float*)(ws + WS_DC);
    const int tid = tid_launder(wid_s), cg = tid & 31, rg = tid >> 5, wid = tid >> 6, lane = tid & 63, fr = lane & 15, fq = lane >> 4;
    ChunkRaw nraw; u32x2 nv[4];
    { const int u0 = blockIdx.x; if (u0 < 4224) { const size_t org0 = (size_t)(u0 >> 3) * 64 * DM + (u0 & 7) * 128; chunk_load_lf(lf + org0, nraw, tid);
#pragma unroll
        for (int i = 0; i < 4; ++i) nv[i] = *(const u32x2*)(vb + org0 + (size_t)(4 * rg + i) * DM + 4 * cg); } }
    for (int u = blockIdx.x; u < 4224; u += gridDim.x) {
        const ChunkRaw raw = nraw; u32x2 cv[4];
#pragma unroll
        for (int i = 0; i < 4; ++i) cv[i] = nv[i];
        { const int un = u + (int)gridDim.x; if (un < 4224) { const size_t orgn = (size_t)(un >> 3) * 64 * DM + (un & 7) * 128; chunk_load_lf(lf + orgn, nraw, tid);
#pragma unroll
            for (int i = 0; i < 4; ++i) nv[i] = *(const u32x2*)(vb + orgn + (size_t)(4 * rg + i) * DM + 4 * cg); } }
        lds_barrier();
        ChunkB cb; chunk_cumsum(raw, cb, T, tid);
        float kd[4][4]; unsigned vw[4][2];
#pragma unroll
        for (int i = 0; i < 4; ++i) { const u32x2 w = cv[i]; vw[i][0] = w.x; vw[i][1] = w.y;
#pragma unroll
            for (int j = 0; j < 4; ++j) kd[i][j] = (1.0f - fexp(cb.lf[i][j])) * fexp(cb.bC[j] - cb.b[i][j]); }
#pragma unroll
        for (int j = 0; j < 4; ++j) {
            u32x2 w; w.x = cvt_pk_bf16(kd[0][j], kd[1][j]); w.y = cvt_pk_bf16(kd[2][j], kd[3][j]);
            *(u32x2*)(KdT + (4 * cg + j) * 144 + rg * 8) = w;
            unsigned short e[4];
#pragma unroll
            for (int i = 0; i < 4; ++i) e[i] = (unsigned short)((j & 1) ? (vw[i][j >> 1] >> 16) : (vw[i][j >> 1] & 0xffff));
            u32x2 x; x.x = (unsigned)e[0] | ((unsigned)e[1] << 16); x.y = (unsigned)e[2] | ((unsigned)e[3] << 16);
            *(u32x2*)(Vt + (4 * cg + j) * 144 + rg * 8) = x;
        }
        if (rg == 0) *(f32x4*)(dc + (size_t)u * 128 + 4 * cg) = (f32x4){fexp(cb.bC[0]), fexp(cb.bC[1]), fexp(cb.bC[2]), fexp(cb.bC[3])};
        lds_barrier();
        bf16x8 bv[2]; u32x2 hold = {0u, 0u};
#pragma unroll
        for (int ks = 0; ks < 2; ++ks) bv[ks] = *(const bf16x8*)(Vt + (wid * 16 + fr) * 144 + ks * 64 + fq * 16);
#pragma unroll
        for (int kb = 0; kb < 8; ++kb) {
            f32x4 a = {0.f, 0.f, 0.f, 0.f};
#pragma unroll
            for (int ks = 0; ks < 2; ++ks) { const bf16x8 af = *(const bf16x8*)(KdT + ((fr >> 2) * 32 + kb * 4 + (fr & 3)) * 144 + ks * 64 + fq * 16); a = __builtin_amdgcn_mfma_f32_16x16x32_bf16(af, bv[ks], a, 0, 0, 0); }
            if (kb & 1) { u32x4 w; w.x = hold.x; w.y = hold.y; w.z = cvt_pk_bf16(a[0], a[1]); w.w = cvt_pk_bf16(a[2], a[3]);
                *(u32x4*)(dS + ((size_t)u * 128 + wid * 16 + fr) * 128 + fq * 32 + (kb - 1) * 4) = w; }
            else { hold.x = cvt_pk_bf16(a[0], a[1]); hold.y = cvt_pk_bf16(a[2], a[3]); }
        }
    }
}

__device__ __forceinline__ void phase_hscan(const Params& p, int L, int wid_s) {
    unsigned char* ws = p.ws; const int j = L >> 1;
    bf16_t* dS = (bf16_t*)(p.out + O_Y); const float* dc = (const float*)(ws + WS_DC);
    const int gtid = blockIdx.x * blockDim.x + tid_launder(wid_s), gsz = gridDim.x * blockDim.x;
    for (int task = gtid; task < 32 * 4096; task += gsz) {
        const int kq = task & 31, v = (task >> 5) & 127, bh = task >> 12, b = bh >> 3, h = bh & 7;
        f32x4 S = {0.f, 0.f, 0.f, 0.f};
        const size_t ustride = (size_t)8 * 16384; bf16_t* ptr = dS + ((size_t)(b * 128) * 8 + h) * 16384 + v * 128 + kq * 4;
        const float* dptr = dc + ((size_t)(b * 128) * 8 + h) * 128 + kq * 4;
        u32x2 w[8]; f32x4 d[8];
#pragma unroll
        for (int i = 0; i < 8; ++i) { w[i] = *(const u32x2*)(ptr + i * ustride); d[i] = *(const f32x4*)(dptr + (size_t)i * 8 * 128); }
        for (int c0 = 0; c0 < 128; c0 += 8) {
            u32x2 wn[8]; f32x4 dn[8];
            if (c0 + 8 < 128) {
#pragma unroll
                for (int i = 0; i < 8; ++i) { wn[i] = *(const u32x2*)(ptr + (size_t)(c0 + 8 + i) * ustride); dn[i] = *(const f32x4*)(dptr + (size_t)(c0 + 8 + i) * 8 * 128); }
            } else {
#pragma unroll
                for (int i = 0; i < 8; ++i) { wn[i] = (u32x2){0u, 0u}; dn[i] = (f32x4){0.f, 0.f, 0.f, 0.f}; }
            }
#pragma unroll
            for (int i = 0; i < 8; ++i) {
                u32x2 o; o.x = cvt_pk_bf16(S[0], S[1]); o.y = cvt_pk_bf16(S[2], S[3]);
#ifndef DIAG_NOSTORE
                *(u32x2*)(ptr + (size_t)(c0 + i) * ustride) = o;
#endif
                const f32x4 ds = {bf_lo(w[i].x), bf_hi(w[i].x), bf_lo(w[i].y), bf_hi(w[i].y)};
                S = d[i] * S + ds;
            }
#pragma unroll
            for (int i = 0; i < 8; ++i) { w[i] = wn[i]; d[i] = dn[i]; }
        }
        float* o = p.out + O_HGP + (((size_t)j * 4 + b) * 8 + h) * 16384 + (size_t)(kq * 4) * 128 + v;
        o[0] = S[0]; o[128] = S[1]; o[256] = S[2]; o[384] = S[3];
    }
#ifndef NO_SAMPLE_SCAN
    for (int task = gtid; task < 128 * 4096; task += gsz) {
        const int vq = task & 31, k = (task >> 5) & 127, bh = task >> 12, b = bh >> 3, h = bh & 7;
        const int u = (512 + b) * 8 + h;
        const size_t so = (((size_t)j * 16 + b) * 8 + h) * 16384 + (size_t)k * 128 + vq * 4;
        const f32x4 S0 = *(const f32x4*)(p.in[I_SHG] + so);
        const float dk = dc[(size_t)u * 128 + k];
        bf16_t* ptr = dS + (size_t)u * 16384 + (size_t)(vq * 4) * 128 + k;
        f32x4 Sf;
#pragma unroll
        for (int i = 0; i < 4; ++i) { const float ds = __uint_as_float((unsigned)ptr[i * 128] << 16); Sf[i] = dk * S0[i] + ds; ptr[i * 128] = (bf16_t)(cvt_pk_bf16(S0[i], 0.f) & 0xffff); }
        *(f32x4*)(p.out + O_HGS + so) = Sf;
    }
#endif
}

__device__ __forceinline__ void phase_hout(const Params& p, int L, int wid_s) {
    unsigned char* ws = p.ws; const int jj = L >> 1;
    float* T = (float*)smem;
    unsigned char* Q1 = smem + 8192;
    unsigned char* Q2 = Q1 + 64 * 272;
    unsigned char* K1 = Q2 + 64 * 272;
    unsigned char* Vt = K1 + 64 * 272;
    unsigned char* St = Vt + 128 * 144;
    unsigned char* Ab = St + 128 * 272;
    float* red = (float*)(Ab + 64 * 144);
    const _Float16* lf = (const _Float16*)(ws + WS_LF); const bf16_t* vb = (const bf16_t*)(ws + WS_VB); const bf16_t* gb = (const bf16_t*)(ws + WS_GB);
    bf16_t* qb = (bf16_t*)(ws + WS_QB); const bf16_t* Sc = (const bf16_t*)(p.out + O_Y);
    const float* gn = p.in[I_HNORMG] + jj * DM;
    const int tid = tid_launder(wid_s), cg = tid & 31, rg = tid >> 5, wid = tid >> 6, lane = tid & 63, fr = lane & 15, fq = lane >> 4;
    ChunkRaw nraw; u32x2 nq[4], nv[4]; u32x4 ns[4];
#define HOUT_LOAD(uu) do { const size_t org_ = (size_t)((uu) >> 3) * 64 * DM + ((uu) & 7) * 128; chunk_load_lf(lf + org_, nraw, tid); \
        _Pragma("unroll") for (int i = 0; i < 4; ++i) { const size_t o_ = org_ + (size_t)(4 * rg + i) * DM + 4 * cg; nq[i] = *(const u32x2*)(qb + o_); nv[i] = *(const u32x2*)(vb + o_); \
            const int idx_ = tid + 512 * i; ns[i] = *(const u32x4*)(Sc + (size_t)(uu) * 16384 + (idx_ >> 4) * 128 + (idx_ & 15) * 8); } } while (0)
    if ((int)blockIdx.x < 4224) HOUT_LOAD((int)blockIdx.x);
    for (int u = blockIdx.x; u < 4224; u += gridDim.x) {
        const int c = u >> 3, h = u & 7; const size_t org = (size_t)c * 64 * DM + h * 128;
        const ChunkRaw raw = nraw; u32x2 cq[4], cv[4]; u32x4 cs[4];
#pragma unroll
        for (int i = 0; i < 4; ++i) { cq[i] = nq[i]; cv[i] = nv[i]; cs[i] = ns[i]; }
        lds_barrier();
        ChunkB cb; chunk_cumsum(raw, cb, T, tid);
#pragma unroll
        for (int i = 0; i < 4; ++i) { const int idx = tid + 512 * i, r = idx >> 4, c8 = (idx & 15) * 8; *(u32x4*)(St + r * 272 + c8 * 2) = cs[i]; }
        unsigned vw[4][2];
#pragma unroll
        for (int i = 0; i < 4; ++i) {
            const u32x2 qw = cq[i]; const u32x2 w = cv[i]; vw[i][0] = w.x; vw[i][1] = w.y;
            const float q[4] = {bf_lo(qw.x), bf_hi(qw.x), bf_lo(qw.y), bf_hi(qw.y)};
            float q1[4], q2[4], k1[4];
#pragma unroll
            for (int j = 0; j < 4; ++j) { const float kk = 1.0f - fexp(cb.lf[i][j]); q1[j] = q[j] * fexp(cb.b[i][j] - cb.bref[j]); q2[j] = q[j] * fexp(cb.b[i][j]); k1[j] = kk * fexp(cb.bref[j] - cb.b[i][j]); }
            u32x2 a; a.x = cvt_pk_bf16(q1[0], q1[1]); a.y = cvt_pk_bf16(q1[2], q1[3]); *(u32x2*)(Q1 + (4 * rg + i) * 272 + cg * 8) = a;
            a.x = cvt_pk_bf16(q2[0], q2[1]); a.y = cvt_pk_bf16(q2[2], q2[3]); *(u32x2*)(Q2 + (4 * rg + i) * 272 + cg * 8) = a;
            a.x = cvt_pk_bf16(k1[0], k1[1]); a.y = cvt_pk_bf16(k1[2], k1[3]); *(u32x2*)(K1 + (4 * rg + i) * 272 + cg * 8) = a;
        }
#pragma unroll
        for (int j = 0; j < 4; ++j) {
            unsigned short e[4];
#pragma unroll
            for (int i = 0; i < 4; ++i) e[i] = (unsigned short)((j & 1) ? (vw[i][j >> 1] >> 16) : (vw[i][j >> 1] & 0xffff));
            u32x2 x; x.x = (unsigned)e[0] | ((unsigned)e[1] << 16); x.y = (unsigned)e[2] | ((unsigned)e[3] << 16);
            *(u32x2*)(Vt + (4 * cg + j) * 144 + rg * 8) = x;
        }
        lds_barrier();
        const int tb = wid & 3, hv = wid >> 2;
        const size_t orow = org + (size_t)(tb * 16 + fr) * DM;
        u32x4 gw8[2];
#pragma unroll
        for (int q = 0; q < 2; ++q) gw8[q] = *(const u32x4*)(gb + orow + hv * 64 + fq * 16 + q * 8);
        { const int un = u + (int)gridDim.x; if (un < 4224) HOUT_LOAD(un); }
#pragma unroll
        for (int q = 0; q < 2; ++q) {
            const int sb = hv * 2 + q; f32x4 a = {0.f, 0.f, 0.f, 0.f};
            if (sb <= tb) {
#pragma unroll
                for (int ks = 0; ks < 4; ++ks) { const bf16x8 af = *(const bf16x8*)(K1 + (sb * 16 + fr) * 272 + ks * 64 + fq * 16); const bf16x8 bf = *(const bf16x8*)(Q1 + (tb * 16 + fr) * 272 + ks * 64 + fq * 16);
                    a = __builtin_amdgcn_mfma_f32_16x16x32_bf16(af, bf, a, 0, 0, 0); }
#pragma unroll
                for (int r = 0; r < 4; ++r) if (sb * 16 + fq * 4 + r > tb * 16 + fr) a[r] = 0.f;
            }
            u32x2 w; w.x = cvt_pk_bf16(a[0], a[1]); w.y = cvt_pk_bf16(a[2], a[3]);
            *(u32x2*)(Ab + (tb * 16 + fr) * 144 + sb * 32 + fq * 8) = w;
        }
        f32x4 o4[4];
#pragma unroll
        for (int vi = 0; vi < 4; ++vi) o4[vi] = (f32x4){0.f, 0.f, 0.f, 0.f};
#pragma unroll
        for (int ks = 0; ks < 4; ++ks) { const bf16x8 bf = *(const bf16x8*)(Q2 + (tb * 16 + fr) * 272 + ks * 64 + fq * 16);
#pragma unroll
            for (int vi = 0; vi < 4; ++vi) { const bf16x8 af = *(const bf16x8*)(St + (hv * 64 + (fr >> 2) * 16 + vi * 4 + (fr & 3)) * 272 + ks * 64 + fq * 16); o4[vi] = __builtin_amdgcn_mfma_f32_16x16x32_bf16(af, bf, o4[vi], 0, 0, 0); } }
        lds_barrier();
#pragma unroll
        for (int ks = 0; ks < 2; ++ks) { const bf16x8 bf = *(const bf16x8*)(Ab + (tb * 16 + fr) * 144 + ks * 64 + fq * 16);
#pragma unroll
            for (int vi = 0; vi < 4; ++vi) { const bf16x8 af = *(const bf16x8*)(Vt + (hv * 64 + (fr >> 2) * 16 + vi * 4 + (fr & 3)) * 144 + ks * 64 + fq * 16); o4[vi] = __builtin_amdgcn_mfma_f32_16x16x32_bf16(af, bf, o4[vi], 0, 0, 0); } }
        float ss = 0.f;
#pragma unroll
        for (int vi = 0; vi < 4; ++vi) ss += (o4[vi][0] * o4[vi][0] + o4[vi][1] * o4[vi][1]) + (o4[vi][2] * o4[vi][2] + o4[vi][3] * o4[vi][3]);
        ss += __shfl_xor(ss, 16); ss += __shfl_xor(ss, 32);
        if (fq == 0) red[hv * 64 + tb * 16 + fr] = ss;
        lds_barrier();
        const float rs = rsqrtf((red[tb * 16 + fr] + red[64 + tb * 16 + fr]) * (1.0f / 128.0f) + EPS);
        u32x2 ow[4];
#pragma unroll
        for (int vi = 0; vi < 4; ++vi) {
            const int vc = hv * 64 + fq * 16 + vi * 4;
            const f32x4 g4 = *(const f32x4*)(gn + h * 128 + vc);
            const unsigned glo = (vi & 1) ? gw8[vi >> 1].z : gw8[vi >> 1].x, ghi = (vi & 1) ? gw8[vi >> 1].w : gw8[vi >> 1].y;
            const float r0 = o4[vi][0] * rs * g4[0] * bf_lo(glo), r1 = o4[vi][1] * rs * g4[1] * bf_hi(glo), r2 = o4[vi][2] * rs * g4[2] * bf_lo(ghi), r3 = o4[vi][3] * rs * g4[3] * bf_hi(ghi);
            ow[vi].x = cvt_pk_bf16(r0, r1); ow[vi].y = cvt_pk_bf16(r2, r3);
        }
#pragma unroll
        for (int q = 0; q < 2; ++q) { u32x4 w; w.x = ow[2 * q].x; w.y = ow[2 * q].y; w.z = ow[2 * q + 1].x; w.w = ow[2 * q + 1].y; *(u32x4*)(qb + orow + hv * 64 + fq * 16 + q * 8) = w; }
    }
}

__device__ __forceinline__ void phase_final(const Params& p, int wid_s) {
    const int tidf = tid_launder(wid_s); const int gtid = blockIdx.x * blockDim.x + tidf, gsz = gridDim.x * blockDim.x, wv = gtid >> 6, nwv = gsz >> 6, lane = tidf & 63;
    const float* ssq = (const float*)(p.ws + WS_SSQP) + (size_t)8 * SSQ_STRIDE; const float* g = p.in[I_NOUTG]; const bf16_t* xb = (const bf16_t*)(p.ws + WS_XB);
    for (int row = wv; row < M_TOK; row += 2 * nwv) {
        const int row2 = row + nwv; const bool has2 = row2 < M_TOK; const int r2 = has2 ? row2 : row;
        u32x4 a[2], b2[2];
#pragma unroll
        for (int i = 0; i < 2; ++i) { a[i] = *(const u32x4*)(xb + (size_t)row * DM + i * 512 + lane * 8); b2[i] = *(const u32x4*)(xb + (size_t)r2 * DM + i * 512 + lane * 8); }
        const float rs = rstd_row(ssq + (size_t)row * 16), rs2 = rstd_row(ssq + (size_t)r2 * 16);
#pragma unroll
        for (int i = 0; i < 2; ++i) {
            const int c = i * 512 + lane * 8; const f32x4 g0 = *(const f32x4*)(g + c), g1 = *(const f32x4*)(g + c + 4);
            float* y = p.out + O_Y + (size_t)row * DM + c;
            *(f32x4*)y = (f32x4){bf_lo(a[i].x), bf_hi(a[i].x), bf_lo(a[i].y), bf_hi(a[i].y)} * rs * g0; *(f32x4*)(y + 4) = (f32x4){bf_lo(a[i].z), bf_hi(a[i].z), bf_lo(a[i].w), bf_hi(a[i].w)} * rs * g1;
            if (has2) { float* y2 = p.out + O_Y + (size_t)row2 * DM + c;
                *(f32x4*)y2 = (f32x4){bf_lo(b2[i].x), bf_hi(b2[i].x), bf_lo(b2[i].y), bf_hi(b2[i].y)} * rs2 * g0; *(f32x4*)(y2 + 4) = (f32x4){bf_lo(b2[i].z), bf_hi(b2[i].z), bf_lo(b2[i].w), bf_hi(b2[i].w)} * rs2 * g1; }
        }
    }
}

constexpr size_t WS_BAR = 2 * MiB + 512 * 1024;
#define XB_CENSUS(j) (64 * (1 + (j)))
#define XB_SUB(j) (64 * (17 + (j)))
#define XB_XGEN(j) (64 * (33 + (j)))
#define XB_TOP (64 * 49)
#define XB_TOPGEN (64 * 50)
constexpr size_t XB_BYTES = 64 * 51 * 4;
__device__ __forceinline__ unsigned xb_ld(unsigned* p) { return __hip_atomic_load(p, __ATOMIC_RELAXED, __HIP_MEMORY_SCOPE_AGENT); }
__device__ __forceinline__ unsigned xb_add(unsigned* p, unsigned v) { return __hip_atomic_fetch_add(p, v, __ATOMIC_RELAXED, __HIP_MEMORY_SCOPE_AGENT); }
struct XBar { unsigned* bar; unsigned x, nloc, nx; };
__device__ __forceinline__ void grid_barrier(const XBar& b, int wid_s) {
    asm volatile("s_waitcnt vmcnt(0) lgkmcnt(0)" ::: "memory");
    __syncthreads();
    if (wid_s == 0) {
        if (tid_launder(wid_s) == 0) {
            const unsigned old = xb_add(&b.bar[XB_SUB(b.x)], 1u), gen = old / b.nloc;
            if (old + 1u == (gen + 1u) * b.nloc) {
                __builtin_amdgcn_fence(__ATOMIC_RELEASE, "agent");
                asm volatile("s_waitcnt vmcnt(0)" ::: "memory");
                const unsigned og = xb_add(&b.bar[XB_TOP], 1u), tg = og / b.nx;
                if (og + 1u == (tg + 1u) * b.nx) xb_add(&b.bar[XB_TOPGEN], 1u);
                else while (xb_ld(&b.bar[XB_TOPGEN]) == tg) __builtin_amdgcn_s_sleep(1);
                xb_add(&b.bar[XB_XGEN(b.x)], 1u);
            } else while (xb_ld(&b.bar[XB_XGEN(b.x)]) == gen) __builtin_amdgcn_s_sleep(1);
        }
        __builtin_amdgcn_fence(__ATOMIC_ACQUIRE, "agent");
        asm volatile("s_waitcnt vmcnt(0)" ::: "memory");
    }
    __syncthreads();
}

enum { OP_PREP = 0, OP_POOLD, OP_POOLG, OP_HIN, OP_HDS, OP_HSCAN, OP_HOUT, OP_HPROJ, OP_UP, OP_DOWN, OP_FINAL };
constexpr int NPH = 24;
__device__ __forceinline__ void phase_decode(int ph, int& op, int& L) {
    if (ph == 0) { op = OP_PREP; L = 0; return; }
    if (ph == 23) { op = OP_FINAL; L = 0; return; }
    int q = ph - 1;
    const int pr = q / 11; q %= 11;
    if (q < 4) { L = 2 * pr; op = q == 0 ? OP_POOLD : q == 1 ? OP_POOLG : q == 2 ? OP_UP : OP_DOWN; }
    else { q -= 4; L = 2 * pr + 1; op = q == 0 ? OP_HIN : q == 1 ? OP_HDS : q == 2 ? OP_HSCAN : q == 3 ? OP_HOUT : q == 4 ? OP_HPROJ : q == 5 ? OP_UP : OP_DOWN; }
}

template <int MASK>
__device__ __forceinline__ void run_op(const Params& p, int op, int L, int wid_s, unsigned long long* tk = nullptr, bool coop = false) {
    unsigned char* ws = p.ws;
    float* xf = p.out + O_Y; bf16_t* xb = (bf16_t*)(ws + WS_XB); float* ssq = (float*)(ws + WS_SSQP);
#define PHON(x) if (!((MASK >> (x)) & 1)) break;
    switch (op) {
    case OP_PREP: PHON(OP_PREP) phase_prep(p, wid_s); break;
    case OP_POOLD: PHON(OP_POOLD) phase_pool_d(p, L, wid_s); break;
    case OP_HDS: PHON(OP_HDS) phase_hds(p, wid_s); break;
    case OP_HSCAN: PHON(OP_HSCAN) phase_hscan(p, L, wid_s); break;
    case OP_HOUT: PHON(OP_HOUT) phase_hout(p, L, wid_s); break;
    case OP_FINAL: PHON(OP_FINAL) phase_final(p, wid_s); break;
    case OP_POOLG: case OP_HPROJ: case OP_DOWN: { PHON(OP_DOWN)
        GemmArgs g; EpiResid e; e.xf = xf; e.xb = xb; e.xin_p = nullptr; e.xin_s = nullptr; e.colscale = nullptr; e.koff_per_pn = 0; e.flags = nullptr;
        g.nM = M_TOK / BM; g.nN = DM / BM;
        if (op == OP_POOLG) { g.A = (const bf16_t*)(ws + WS_DBUF); g.lda = DM; g.K = 256; g.Bt = (const bf16_t*)(ws + WS_WPOOL) + (size_t)(L >> 1) * 4 * 65536; g.ldb = 256;
            e.colscale = p.in[I_POOLSC] + (L >> 1) * DM; e.koff_per_pn = 256; e.ssq = ssq + (size_t)(2 * L + 1) * SSQ_STRIDE;
            if (L == 0) { e.xin_p = p.in[I_XP]; e.xin_s = p.in[I_XS]; } }
        else if (op == OP_HPROJ) { g.A = (const bf16_t*)(ws + WS_QB); g.lda = DM; g.K = DM; g.Bt = (const bf16_t*)(ws + WS_WOUT) + (size_t)(L >> 1) * DM * DM; g.ldb = DM; e.ssq = ssq + (size_t)(2 * L + 1) * SSQ_STRIDE; }
        else { g.A = (const bf16_t*)(ws + WS_HID); g.lda = FF; g.K = FF; g.Bt = (const bf16_t*)(ws + WS_WDN) + (size_t)L * DM * FF; g.ldb = FF; e.ssq = ssq + (size_t)(2 * L + 2) * SSQ_STRIDE;
            if (coop && gridDim.x == 256) e.flags = (unsigned*)(ws + WS_BAR + XB_BYTES) + L * 16; }
        gemm_phase(g, e, wid_s, tk);
        if (op == OP_DOWN && L < 3) {
            const int nwg3 = e.flags ? 32 : 528 - 2 * (int)gridDim.x;
            if (nwg3 > 0 && (int)blockIdx.x >= nwg3) prep_weights_layer(p, L + 1, (int)blockIdx.x - nwg3, (int)gridDim.x - nwg3, wid_s);
            else if (nwg3 <= 0) prep_weights_layer(p, L + 1, (int)blockIdx.x, (int)gridDim.x, wid_s);
        }
    } break;
    case OP_HIN: { PHON(OP_HIN)
        GemmArgs g; g.A = xb; g.lda = DM; g.K = DM; g.Bt = (const bf16_t*)(ws + WS_WIN) + (size_t)(L >> 1) * 4 * DM * DM; g.ldb = DM; g.nM = M_TOK / BM; g.nN = 4 * DM / BM;
        EpiHin e; e.ssq = ssq + (size_t)(2 * L) * SSQ_STRIDE; e.lb = (const float*)(ws + WS_LB) + L * DM; e.ws = ws;
        gemm_phase(g, e, wid_s, tk);
    } break;
    case OP_UP: { PHON(OP_UP)
        GemmArgs g; g.A = xb; g.lda = DM; g.K = DM; g.Bt = (const bf16_t*)(ws + WS_WUP) + (size_t)L * 2 * FF * DM; g.ldb = DM; g.nM = 136; g.nN = 2 * FF / BM;
        EpiUp e; e.ssq = ssq + (size_t)(2 * L + 1) * SSQ_STRIDE; e.cw = p.in[I_CONVW] + (size_t)L * 3 * FF; e.cb = p.in[I_CONVB] + (size_t)L * FF; e.hist = p.in[I_SCONV] + (size_t)L * 16 * 2 * FF;
        e.hid = (bf16_t*)(ws + WS_HID); e.cvp = p.out + O_CVP + (size_t)L * 4 * 2 * FF; e.cvs = p.out + O_CVS + (size_t)L * 16 * 2 * FF;
        gemm_phase(g, e, wid_s, tk);
    } break;
    }
#undef PHON
}

__global__ void __launch_bounds__(512, 2) mega(Params p, int ph_lo, int ph_hi) {
    const int wid_s = __builtin_amdgcn_readfirstlane((int)(threadIdx.x >> 6));
    XBar xb; xb.bar = (unsigned*)(p.ws + WS_BAR); xb.x = (unsigned)__builtin_amdgcn_s_getreg((3 << 11) | 20) & 0xFu; xb.nloc = 1u; xb.nx = 1u;
    if (threadIdx.x == 0) (void)xb_add(&xb.bar[XB_CENSUS(xb.x)], 1u);
#ifdef REPORT_MASK
    unsigned long long t_acc = 0;
#endif
    for (int ph = ph_lo; ph < ph_hi; ++ph) {
        int op, L; phase_decode(ph, op, L);
#ifdef REPORT_MASK
        const unsigned long long t_ph0 = __builtin_amdgcn_s_memrealtime();
#endif
        switch (op) {
        case OP_PREP: run_op<1 << OP_PREP>(p, OP_PREP, L, wid_s); break;
        case OP_POOLD: run_op<1 << OP_POOLD>(p, OP_POOLD, L, wid_s); break;
        case OP_POOLG: run_op<1 << OP_DOWN>(p, OP_POOLG, L, wid_s); break;
        case OP_HIN: run_op<1 << OP_HIN>(p, OP_HIN, L, wid_s); break;
        case OP_HDS: run_op<1 << OP_HDS>(p, OP_HDS, L, wid_s); break;
        case OP_HSCAN: run_op<1 << OP_HSCAN>(p, OP_HSCAN, L, wid_s); break;
        case OP_HOUT: run_op<1 << OP_HOUT>(p, OP_HOUT, L, wid_s); break;
        case OP_HPROJ: run_op<1 << OP_DOWN>(p, OP_HPROJ, L, wid_s); break;
#if defined(REPORT_KLOOP) && REPORT_KLOOP == 8
        case OP_UP: run_op<1 << OP_UP>(p, OP_UP, L, wid_s, &t_acc); break;
#else
        case OP_UP: run_op<1 << OP_UP>(p, OP_UP, L, wid_s); break;
#endif
#if defined(REPORT_KLOOP) && REPORT_KLOOP == 9
        case OP_DOWN: run_op<1 << OP_DOWN>(p, OP_DOWN, L, wid_s, &t_acc); break;
#else
        case OP_DOWN: run_op<1 << OP_DOWN>(p, OP_DOWN, L, wid_s, nullptr, true); break;
#endif
        default: run_op<1 << OP_FINAL>(p, OP_FINAL, L, wid_s); break;
        }
        if (ph + 1 < ph_hi) {
            if (ph == ph_lo) {
                cg::this_grid().sync();
                unsigned mine = 0u, cnt = 0u;
#pragma unroll
                for (unsigned j = 0; j < 16; ++j) { const unsigned c = xb_ld(&xb.bar[XB_CENSUS(j)]); cnt += c > 0u ? 1u : 0u; mine = j == xb.x ? c : mine; }
                xb.nloc = (unsigned)__builtin_amdgcn_readfirstlane((int)(mine > 0u ? mine : 1u)); xb.nx = (unsigned)__builtin_amdgcn_readfirstlane((int)(cnt > 0u ? cnt : 1u));
            } else grid_barrier(xb, wid_s);
        }
#ifdef REPORT_MASK
        if ((REPORT_MASK >> op) & 1) t_acc += __builtin_amdgcn_s_memrealtime() - t_ph0;
#endif
    }
#ifdef REPORT_MASK
    { const unsigned long long t_e = __builtin_amdgcn_s_memrealtime(); while (__builtin_amdgcn_s_memrealtime() - t_e < t_acc) __builtin_amdgcn_s_sleep(16); }
#endif
}
template <int OP>
__global__ void __launch_bounds__(512, 2) phase_kernel(Params p, int L) {
    const int wid_s = __builtin_amdgcn_readfirstlane((int)(threadIdx.x >> 6));
    constexpr int MASK = (OP == OP_POOLG || OP == OP_HPROJ) ? (1 << OP_DOWN) : (1 << OP);
    run_op<MASK>(p, OP, L, wid_s);
}
template <int OP> static void launch_phase(const Params& p, int L, int grid, hipStream_t stream) {
    static bool attr = false;
    if (!attr) { (void)hipFuncSetAttribute((const void*)phase_kernel<OP>, hipFuncAttributeMaxDynamicSharedMemorySize, LDS_BYTES); attr = true; }
    hipLaunchKernelGGL(phase_kernel<OP>, dim3(grid), dim3(512), LDS_BYTES, stream, p, L);
}

extern "C" void kernel_launch(void* const* d_in, const int* in_sizes, int n_in, void* d_out, int out_size, void* d_ws, size_t ws_size, hipStream_t stream) {
    static int grid_blocks = 0;
    if (!grid_blocks) {
        hipFuncSetAttribute((const void*)mega, hipFuncAttributeMaxDynamicSharedMemorySize, LDS_BYTES);
        int dev = 0, cus = 0, per_cu = 0; hipGetDevice(&dev);
        hipDeviceGetAttribute(&cus, hipDeviceAttributeMultiprocessorCount, dev);
        hipOccupancyMaxActiveBlocksPerMultiprocessor(&per_cu, mega, 512, LDS_BYTES);
        if (per_cu < 1) per_cu = 1;
        grid_blocks = cus * 1;
        if (ws_size < WS_NEED) fprintf(stderr, "workspace too small: %zu < %zu\n", ws_size, (size_t)WS_NEED);
    }
    if (ws_size < WS_NEED || n_in != 18) return;
    Params p{};
    for (int i = 0; i < 18; ++i) p.in[i] = (const float*)d_in[i];
    p.out = (float*)d_out; p.ws = (unsigned char*)d_ws;
#if defined(BISECT_N)
    for (int ph = 0; ph < BISECT_N; ++ph) hipLaunchKernelGGL(mega, dim3(grid_blocks), dim3(512), LDS_BYTES, stream, p, ph, ph + 1);
#elif MK_SINGLE
    (void)hipMemsetAsync((unsigned char*)d_ws + WS_BAR, 0, XB_BYTES + 256, stream);
    int lo = 0, hi = NPH; void* args[] = {&p, &lo, &hi};
    hipError_t e = hipLaunchCooperativeKernel((const void*)mega, dim3(grid_blocks), dim3(512), args, LDS_BYTES, stream);
    if (e != hipSuccess) fprintf(stderr, "cooperative launch failed: %s (grid %d)\n", hipGetErrorString(e), grid_blocks);
#else
    for (int ph = 0; ph < NPH; ++ph) {
        int op, L;
        if (ph == 0) { op = OP_PREP; L = 0; } else if (ph == 23) { op = OP_FINAL; L = 0; }
        else { int q = ph - 1; const int pr = q / 11; q %= 11;
            if (q < 4) { L = 2 * pr; op = q == 0 ? OP_POOLD : q == 1 ? OP_POOLG : q == 2 ? OP_UP : OP_DOWN; }
            else { q -= 4; L = 2 * pr + 1; op = q == 0 ? OP_HIN : q == 1 ? OP_HDS : q == 2 ? OP_HSCAN : q == 3 ? OP_HOUT : q == 4 ? OP_HPROJ : q == 5 ? OP_UP : OP_DOWN; } }
        switch (op) {
        case OP_PREP: launch_phase<OP_PREP>(p, L, grid_blocks, stream); break;
        case OP_POOLD: launch_phase<OP_POOLD>(p, L, grid_blocks, stream); break;
        case OP_POOLG: launch_phase<OP_POOLG>(p, L, grid_blocks, stream); break;
        case OP_HIN: launch_phase<OP_HIN>(p, L, grid_blocks, stream); break;
        case OP_HDS: launch_phase<OP_HDS>(p, L, grid_blocks, stream); break;
        case OP_HSCAN: launch_phase<OP_HSCAN>(p, L, grid_blocks, stream); break;
        case OP_HOUT: launch_phase<OP_HOUT>(p, L, grid_blocks, stream); break;
        case OP_HPROJ: launch_phase<OP_HPROJ>(p, L, grid_blocks, stream); break;
        case OP_UP: launch_phase<OP_UP>(p, L, grid_blocks, stream); break;
        case OP_DOWN: launch_phase<OP_DOWN>(p, L, grid_blocks, stream); break;
        default: launch_phase<OP_FINAL>(p, L, grid_blocks, stream); break;
        }
    }
#endif
}
```

```cpp
#include <hip/hip_runtime.h>
#include <hip/hip_cooperative_groups.h>
#include <cstdint>
#include <cstdio>
namespace cg = cooperative_groups;


#ifndef MK_SINGLE
#define MK_SINGLE 1
#endif

typedef unsigned short bf16_t;
typedef short bf16x8 __attribute__((ext_vector_type(8)));
typedef float f32x4 __attribute__((ext_vector_type(4)));
typedef float f32x2 __attribute__((ext_vector_type(2)));
typedef unsigned u32x4 __attribute__((ext_vector_type(4)));
typedef unsigned u32x2 __attribute__((ext_vector_type(2)));
typedef _Float16 h16x4 __attribute__((ext_vector_type(4)));

constexpr int M_TOK = 33792, MP = 32768, DM = 1024, FF = 2816, SEQ = 8192, DSEQ = 64;
constexpr float EPS = 1e-6f;
constexpr int BM = 256, BK = 64, HALF = 128, HT = HALF * BK, NXCD = 8, WGM = 8;
constexpr int LDS_RS = 256 * 528;
constexpr int LDS_BYTES = 256 * 528 + 1024;

constexpr size_t MiB = (size_t)1 << 20;
constexpr size_t WS_SSQ = 0;
constexpr size_t WS_LB = 2 * MiB;
constexpr size_t WS_DC = 3 * MiB;
constexpr size_t WS_W = 8 * MiB;
constexpr size_t WS_WUP = WS_W, WS_WDN = WS_W + 44 * MiB, WS_WIN = WS_W + 66 * MiB, WS_WOUT = WS_W + 82 * MiB, WS_WPOOL = WS_W + 86 * MiB;
constexpr size_t WS_XB = 96 * MiB;
constexpr size_t WS_SCR = 162 * MiB;
constexpr size_t WS_HID = WS_SCR, WS_DBUF = WS_SCR, WS_DS = WS_XB  ;
constexpr size_t WS_LF = WS_SCR + 66 * MiB, WS_QB = WS_SCR + 132 * MiB, WS_VB = WS_SCR + 198 * MiB, WS_GB = WS_SCR + 264 * MiB;
constexpr size_t WS_SSQP = WS_SCR + 330 * MiB;
constexpr size_t SSQ_STRIDE = (size_t)M_TOK * 16;
constexpr size_t WS_NEED = WS_SSQP + 9 * SSQ_STRIDE * 4;

constexpr size_t O_Y = 0, O_POOLP = 34603008, O_POOLS = 34725888, O_HGP = 35217408, O_HGS = 36265984, O_CVP = 40460288, O_CVS = 40550400;

struct Params { const float* in[18]; float* out; unsigned char* ws; };
enum { I_XP = 0, I_XS, I_SPOOL, I_SHG, I_SCONV, I_NMIXG, I_POOLW, I_POOLSC, I_HWIN, I_LBLOG, I_HNORMG, I_HWOUT, I_NFFNG, I_WUP, I_CONVW, I_CONVB, I_WDN, I_NOUTG };

extern __shared__ __attribute__((aligned(16))) unsigned char smem[];

typedef __bf16 bf16x2_t __attribute__((ext_vector_type(2)));
__device__ __forceinline__ unsigned cvt_pk_bf16(float lo, float hi) { const f32x2 v = {lo, hi}; const bf16x2_t b = __builtin_convertvector(v, bf16x2_t); return __builtin_bit_cast(unsigned, b); }
__device__ __forceinline__ float bf_lo(unsigned w) { return __uint_as_float(w << 16); }
__device__ __forceinline__ float bf_hi(unsigned w) { return __uint_as_float(w & 0xffff0000u); }
__device__ __forceinline__ float fexp(float x) { return __builtin_amdgcn_exp2f(x * 1.4426950408889634f); }
__device__ __forceinline__ float flog(float x) { return __builtin_amdgcn_logf(x) * 0.6931471805599453f; }
__device__ __forceinline__ float sigmoidf_(float z) { return __builtin_amdgcn_rcpf(1.0f + __builtin_amdgcn_exp2f(z * -1.4426950408889634f)); }
__device__ __forceinline__ float rstd_of(float ssq) { return rsqrtf(ssq * (1.0f / 1024.0f) + EPS); }
__device__ __forceinline__ float rstd_row(const float* sp) { const f32x4 a = *(const f32x4*)sp, b = *(const f32x4*)(sp + 4), c = *(const f32x4*)(sp + 8), d = *(const f32x4*)(sp + 12);
    const f32x4 t = (a + b) + (c + d); return rstd_of((t[0] + t[1]) + (t[2] + t[3])); }

__device__ __forceinline__ const char* uniform_ptr(const void* p) { const unsigned long long v = (unsigned long long)p; const unsigned lo = __builtin_amdgcn_readfirstlane((unsigned)v), hi = __builtin_amdgcn_readfirstlane((unsigned)(v >> 32)); return (const char*)(((unsigned long long)hi << 32) | lo); }
template <int NOP>
__device__ __forceinline__ void glds16(const char* sbase, unsigned voff, unsigned lds_addr) {
    if (NOP) asm volatile("s_mov_b32 m0, %2\n\ts_nop 4\n\tglobal_load_lds_dwordx4 %0, %1" :: "v"(voff), "s"(sbase), "s"(lds_addr) : "memory", "m0");
    else asm volatile("s_mov_b32 m0, %2\n\ts_nop 0\n\tglobal_load_lds_dwordx4 %0, %1" :: "v"(voff), "s"(sbase), "s"(lds_addr) : "memory", "m0");
}
__device__ __forceinline__ int tid_launder(int wid_s) { int l; asm volatile("v_mbcnt_lo_u32_b32 %0, -1, 0\n\tv_mbcnt_hi_u32_b32 %0, -1, %0" : "=v"(l)); return wid_s * 64 + l; }

__device__ __forceinline__ int lds_byte(int r, int c) { int st = (r >> 4) * 2 + (c >> 5), rr = r & 15, cc = c & 31, ob = rr * 64 + cc * 2; return st * 1024 + (ob ^ (((ob >> 9) & 1) << 5)); }
__device__ __forceinline__ void stage_rc(int b, int& R, int& C) { int st = b / 1024, sb = b % 1024, swz = sb ^ (((sb >> 9) & 1) << 5); R = (st >> 1) * 16 + swz / 64; C = (st & 1) * 32 + (swz % 64) / 2; }

struct Unit { int pm, pn, kh; };
__device__ __forceinline__ bool unit_next(int i, int nM, int nN, Unit& u) {
    const int nwg = nM * nN; const long L = (long)i * gridDim.x + blockIdx.x; if (L >= nwg) return false;
    int wgid = (int)L; { const int q = nwg / NXCD, r = nwg % NXCD, xcd = wgid % NXCD, off = wgid / NXCD; wgid = (xcd < r ? xcd * (q + 1) : r * (q + 1) + (xcd - r) * q) + off; }
    const int nig = WGM * nN, gid = wgid / nig, fm = gid * WGM, gsz = (nM - fm) < WGM ? (nM - fm) : WGM;
    u.pm = fm + ((wgid % nig) % gsz); u.pn = (wgid % nig) / gsz; u.kh = -1; return true;
}

struct GemmArgs { const bf16_t* A; const bf16_t* Bt; int lda, ldb, K, nM, nN; };

#define LAS __attribute__((address_space(3)))
template <class Epi>
__device__ __forceinline__ void gemm_phase(const GemmArgs g, const Epi& E, int wid_s, unsigned long long* tk = nullptr) {
    LAS unsigned char* lds = (LAS unsigned char*)smem;
    constexpr int HTB = HT * 2;
#define SA(b, h) (((b) * 2 + (h)) * HTB)
#define SB(b, h) ((4 + (b) * 2 + (h)) * HTB)
#define STAGE(bufoff, gbase, voff) do { _Pragma("unroll") for (int _i = 0; _i < 2; ++_i) glds16<0>((gbase), (voff)[_i], ldsb + (unsigned)((bufoff) + _i * 8192)); } while (0)
#define STAGE0(bufoff, gbase, voff) do { _Pragma("unroll") for (int _i = 0; _i < 2; ++_i) glds16<1>((gbase), (voff)[_i], ldsb + (unsigned)((bufoff) + _i * 8192)); } while (0)
#define LDA(dst, b, h) do { _Pragma("unroll") for (int m = 0; m < 4; ++m) _Pragma("unroll") for (int k = 0; k < 2; ++k) dst[m][k] = *(const LAS bf16x8*)(lds + SA(b, h) + aoff + m * 2048 + k * 1024); } while (0)
#define LDB(dst, b, h) do { _Pragma("unroll") for (int n = 0; n < 2; ++n) _Pragma("unroll") for (int k = 0; k < 2; ++k) dst[n][k] = *(const LAS bf16x8*)(lds + SB(b, h) + boff + n * 2048 + k * 1024); } while (0)
#define MMA(ai, bj, At_, Bt_) do { __builtin_amdgcn_s_setprio(1); _Pragma("unroll") for (int m = 0; m < 4; ++m) _Pragma("unroll") for (int n = 0; n < 2; ++n) _Pragma("unroll") for (int k = 0; k < 2; ++k) \
      acc[ai][bj][m][n] = __builtin_amdgcn_mfma_f32_16x16x32_bf16(Bt_[n][k], At_[m][k], acc[ai][bj][m][n], 0, 0, 0); \
    __builtin_amdgcn_s_setprio(0); } while (0)
#define WAIT_V(n) asm volatile("s_waitcnt vmcnt(" #n ")" ::: "memory")
#define WAIT_L(n) asm volatile("s_waitcnt lgkmcnt(" #n ")" ::: "memory")
#define BAR __builtin_amdgcn_s_barrier()
#define SCHED __builtin_amdgcn_sched_barrier(0)
    const int tid = tid_launder(wid_s), wid = __builtin_amdgcn_readfirstlane(tid >> 6), lane = tid & 63, wr = wid >> 2, wc = wid & 3, fr = lane & 15, fq = lane >> 4;
    const int nt_full = g.K / BK;
    unsigned voffA[2], voffB[2];
#pragma unroll
    for (int i = 0; i < 2; ++i) { int R, C; stage_rc(tid * 16 + i * 8192, R, C); const int rho = R & 31, Rb = (R & ~31) + 8 * ((rho & 15) >> 2) + 4 * (rho >> 4) + (rho & 3);
        voffA[i] = (unsigned)(R * g.lda + C) * 2u; voffB[i] = (unsigned)(Rb * g.ldb + C) * 2u; }
    const size_t kstep = (size_t)(BK * 2), hstepA = (size_t)HALF * g.lda * 2, hstepB = (size_t)HALF * g.ldb * 2;
    const unsigned ldsb = (unsigned)__builtin_amdgcn_readfirstlane((int)(unsigned)(unsigned long long)(LAS unsigned char*)smem) + (unsigned)wid * 1024u;
    const int aoff = lds_byte(wr * 64 + fr, fq * 8), boff = lds_byte(wc * 32 + fr, fq * 8);
    Unit u;
    for (int it = 0; E.next(it, g.nM, g.nN, u); ++it) {
        const int nt = u.kh < 0 ? nt_full : nt_full / 2, kh0 = u.kh > 0 ? (nt_full / 2) * BK : 0;
        const char* cA = uniform_ptr(g.A + E.a_row0(u) * (long)g.lda + E.a_koff(u) + kh0);
        const char* cB = uniform_ptr(g.Bt + (long)u.pn * BM * g.ldb + kh0);
        f32x4 acc[2][2][4][2];
#pragma unroll
        for (int a = 0; a < 2; ++a)
#pragma unroll
            for (int b = 0; b < 2; ++b)
#pragma unroll
                for (int m = 0; m < 4; ++m)
#pragma unroll
                    for (int n = 0; n < 2; ++n) acc[a][b][m][n] = (f32x4){0.f, 0.f, 0.f, 0.f};
        bf16x8 At[4][2], B0[2][2], B1[2][2];
#ifdef REPORT_KLOOP
        const unsigned long long tk0 = __builtin_amdgcn_s_memrealtime();
#endif
        STAGE0(SB(0, 0), cB, voffB); STAGE0(SA(0, 0), cA, voffA); STAGE0(SB(0, 1), cB + hstepB, voffB); STAGE0(SA(0, 1), cA + hstepA, voffA);
        if (wr == 1) BAR;
        WAIT_V(4); BAR;
        STAGE0(SB(1, 0), cB + kstep, voffB); STAGE0(SA(1, 0), cA + kstep, voffA); STAGE0(SB(1, 1), cB + hstepB + kstep, voffB);
        WAIT_V(6); BAR;
        for (int t = 0; t < nt - 2; t += 2) {
            const char* a1 = cA + (size_t)(t + 1) * kstep; const char* a2 = cA + (size_t)(t + 2) * kstep; const char* b2 = cB + (size_t)(t + 2) * kstep;
            const char* a3 = a2 + kstep; const char* b3 = b2 + kstep;
            LDB(B0, 0, 0); SCHED; LDA(At, 0, 0); STAGE(SA(1, 1), a1 + hstepA, voffA);
            WAIT_L(8); BAR; WAIT_L(0); MMA(0, 0, At, B0); BAR; SCHED;
            LDB(B1, 0, 1); STAGE(SB(0, 0), b2, voffB);
            BAR; WAIT_L(0); MMA(0, 1, At, B1); BAR;
            LDA(At, 0, 1); STAGE(SA(0, 0), a2, voffA);
            BAR; WAIT_L(0); MMA(1, 0, At, B0); BAR; SCHED;
            STAGE(SB(0, 1), b2 + hstepB, voffB);
            WAIT_V(6); BAR; MMA(1, 1, At, B1); BAR;
            LDB(B0, 1, 0); SCHED; LDA(At, 1, 0); STAGE(SA(0, 1), a2 + hstepA, voffA);
            WAIT_L(8); BAR; WAIT_L(0); MMA(0, 0, At, B0); BAR; SCHED;
            LDB(B1, 1, 1); STAGE(SB(1, 0), b3, voffB);
            BAR; WAIT_L(0); MMA(0, 1, At, B1); BAR;
            LDA(At, 1, 1); STAGE(SA(1, 0), a3, voffA);
            BAR; WAIT_L(0); MMA(1, 0, At, B0); BAR; SCHED;
            STAGE(SB(1, 1), b3 + hstepB, voffB);
            WAIT_V(6); BAR; MMA(1, 1, At, B1); BAR;
        }
        { LDB(B0, 0, 0); LDA(At, 0, 0); STAGE0(SA(1, 1), cA + (size_t)(nt - 1) * kstep + hstepA, voffA);
          BAR; WAIT_L(0); MMA(0, 0, At, B0); BAR;
          LDB(B1, 0, 1); BAR; WAIT_L(0); MMA(0, 1, At, B1); BAR;
          LDA(At, 0, 1); WAIT_V(4); BAR; WAIT_L(0); MMA(1, 0, At, B0); MMA(1, 1, At, B1); BAR; }
        { LDB(B0, 1, 0); LDA(At, 1, 0); WAIT_V(2); BAR; WAIT_L(0); MMA(0, 0, At, B0); BAR;
          LDB(B1, 1, 1); WAIT_V(0); BAR; WAIT_L(0); MMA(0, 1, At, B1); BAR;
          LDA(At, 1, 1); BAR; WAIT_L(0); MMA(1, 0, At, B0); MMA(1, 1, At, B1); BAR; }
        if (wr == 0) BAR;
#ifdef REPORT_KLOOP
        if (tk) *tk += __builtin_amdgcn_s_memrealtime() - tk0;
#endif
        { int l2_; asm volatile("v_mbcnt_lo_u32_b32 %0, -1, 0\n\tv_mbcnt_hi_u32_b32 %0, -1, %0" : "=v"(l2_)); const int fr_ = l2_ & 15, fq_ = l2_ >> 4;
          E(acc, u, wr, wc, fr_, fq_); }
        asm volatile("s_waitcnt vmcnt(0) lgkmcnt(0)" ::: "memory");
        __syncthreads();
    }
}

__device__ __forceinline__ f32x4 ldg4(const bf16_t* p) { const u32x2 w = *(const u32x2*)p; return (f32x4){bf_lo(w.x), bf_hi(w.x), bf_lo(w.y), bf_hi(w.y)}; }
struct EpiResid {
    const float* xin_p; const float* xin_s; float* xf; bf16_t* xb; float* ssq; const float* colscale; int koff_per_pn;
    unsigned* flags;
    __device__ __forceinline__ bool next(int it, int nM, int nN, Unit& u) const {
        if (!flags) return unit_next(it, nM, nN, u);
        const int L = it * (int)gridDim.x + (int)blockIdx.x;
        if (L < 512) return unit_next(it, 128, 4, u);
        const int s = L - 512; if (s >= 32) return false;
        u.pm = 128 + (s >> 3); u.pn = (s >> 1) & 3; u.kh = s & 1; return true;
    }
    __device__ __forceinline__ long a_row0(const Unit& u) const { return (long)u.pm * BM; }
    __device__ __forceinline__ int a_koff(const Unit& u) const { return u.pn * koff_per_pn; }
    __device__ __forceinline__ void operator()(f32x4 (&acc)[2][2][4][2], const Unit& u, int wr, int wc, int fr, int fq) const {
        unsigned* flag = flags ? flags + ((u.pm - 128) * 4 + u.pn) : nullptr;
        if (u.kh == 1) {
            if (wr == 0 && wc == 0) {
                while (__hip_atomic_load(flag, __ATOMIC_RELAXED, __HIP_MEMORY_SCOPE_AGENT) == 0u) __builtin_amdgcn_s_sleep(2);
                __builtin_amdgcn_fence(__ATOMIC_ACQUIRE, "agent");
                asm volatile("s_waitcnt vmcnt(0)" ::: "memory");
            }
            __syncthreads();
        }
        const bool part = u.kh == 0;
        f32x4 csv[2][2];
#pragma unroll
        for (int bj = 0; bj < 2; ++bj)
#pragma unroll
            for (int n = 0; n < 2; ++n) csv[bj][n] = colscale ? *(const f32x4*)(colscale + u.pn * BM + bj * HALF + wc * 32 + fq * 8 + 4 * n) : (f32x4){1.f, 1.f, 1.f, 1.f};
#pragma unroll
        for (int ai = 0; ai < 2; ++ai)
#pragma unroll
            for (int m = 0; m < 4; ++m) {
                const int row = u.pm * BM + ai * HALF + wr * 64 + m * 16 + fr;
                const float* xr = xin_p ? (row < MP ? xin_p + (size_t)row * DM : xin_s + (size_t)(row - MP) * DM) : xf + (size_t)row * DM;
                const bool from_bf = !xin_p && u.kh != 1;
                float ss = 0.f;
#pragma unroll
                for (int bj = 0; bj < 2; ++bj) {
                    const int col = u.pn * BM + bj * HALF + wc * 32 + fq * 8;
                    f32x4 v0 = acc[ai][bj][m][0], v1 = acc[ai][bj][m][1];
                    if (colscale) { v0 = v0 * csv[bj][0]; v1 = v1 * csv[bj][1]; }
                    if (from_bf) { const u32x4 xw = *(const u32x4*)(xb + (size_t)row * DM + col);
                        v0 = v0 + (f32x4){bf_lo(xw.x), bf_hi(xw.x), bf_lo(xw.y), bf_hi(xw.y)}; v1 = v1 + (f32x4){bf_lo(xw.z), bf_hi(xw.z), bf_lo(xw.w), bf_hi(xw.w)}; }
                    else { v0 = v0 + *(const f32x4*)(xr + col); v1 = v1 + *(const f32x4*)(xr + col + 4); }
                    if (part) { *(f32x4*)(xf + (size_t)row * DM + col) = v0; *(f32x4*)(xf + (size_t)row * DM + col + 4) = v1; }
                    else {
                        u32x4 w; w.x = cvt_pk_bf16(v0[0], v0[1]); w.y = cvt_pk_bf16(v0[2], v0[3]); w.z = cvt_pk_bf16(v1[0], v1[1]); w.w = cvt_pk_bf16(v1[2], v1[3]);
                        *(u32x4*)(xb + (size_t)row * DM + col) = w;
                        ss += ((v0[0] * v0[0] + v0[1] * v0[1]) + (v0[2] * v0[2] + v0[3] * v0[3])) + ((v1[0] * v1[0] + v1[1] * v1[1]) + (v1[2] * v1[2] + v1[3] * v1[3]));
                    }
                }
                ss += __shfl_xor(ss, 16); ss += __shfl_xor(ss, 32);
                if (fq == 0 && !part) ssq[(size_t)row * 16 + u.pn * 4 + wc] = ss;
                asm volatile("" ::: "memory");
            }
        if (part) {
            asm volatile("s_waitcnt vmcnt(0)" ::: "memory");
            __syncthreads();
            if (wr == 0 && wc == 0 && fr == 0 && fq == 0) {
                __builtin_amdgcn_fence(__ATOMIC_RELEASE, "agent");
                asm volatile("s_waitcnt vmcnt(0)" ::: "memory");
                __hip_atomic_store(flag, 1u, __ATOMIC_RELAXED, __HIP_MEMORY_SCOPE_AGENT);
            }
        }
    }
};

struct EpiHin {
    __device__ __forceinline__ bool next(int it, int nM, int nN, Unit& u) const { return unit_next(it, nM, nN, u); }
    const float* ssq; const float* lb; unsigned char* ws;
    __device__ __forceinline__ long a_row0(const Unit& u) const { return (long)u.pm * BM; }
    __device__ __forceinline__ int a_koff(const Unit&) const { return 0; }
    __device__ __forceinline__ void operator()(f32x4 (&acc)[2][2][4][2], const Unit& u, int wr, int wc, int fr, int fq) const {
        const int sec = u.pn >> 2;
        float* rsT = (float*)(smem + LDS_RS);
        { const int t = (wr * 4 + wc) * 64 + fq * 16 + fr; if (t < 256) rsT[t] = rstd_row(ssq + (size_t)(u.pm * BM + t) * 16); }
        f32x4 lbv[2][2];
#pragma unroll
        for (int bj = 0; bj < 2; ++bj)
#pragma unroll
            for (int n = 0; n < 2; ++n) lbv[bj][n] = sec == 1 ? *(const f32x4*)(lb + (u.pn & 3) * BM + bj * HALF + wc * 32 + fq * 8 + 4 * n) : (f32x4){0.f, 0.f, 0.f, 0.f};
        __syncthreads();
#pragma unroll
        for (int ai = 0; ai < 2; ++ai)
#pragma unroll
            for (int m = 0; m < 4; ++m) {
                const int row = u.pm * BM + ai * HALF + wr * 64 + m * 16 + fr;
                const float rs = rsT[ai * HALF + wr * 64 + m * 16 + fr];
#pragma unroll
                for (int bj = 0; bj < 2; ++bj) {
                    const int cs = (u.pn & 3) * BM + bj * HALF + wc * 32 + fq * 8;
                    const size_t o = (size_t)row * DM + cs;
                    u32x4 w;
#pragma unroll
                    for (int n = 0; n < 2; ++n) {
                        const f32x4 z = acc[ai][bj][m][n] * rs; unsigned p0, p1;
                        if (sec == 1) {
                            const f32x4 l4 = lbv[bj][n]; h16x4 h;
#pragma unroll
                            for (int j = 0; j < 4; ++j) { const float f = l4[j] + (1.0f - l4[j]) * sigmoidf_(z[j]); h[j] = (_Float16)flog(f); }
                            const u32x2 hw = __builtin_bit_cast(u32x2, h); p0 = hw.x; p1 = hw.y;
                        } else {
                            f32x4 r = z;
                            if (sec != 2) {
#pragma unroll
                                for (int j = 0; j < 4; ++j) r[j] = z[j] * sigmoidf_(z[j]);
                            }
                            p0 = cvt_pk_bf16(r[0], r[1]); p1 = cvt_pk_bf16(r[2], r[3]);
                        }
                        if (n == 0) { w.x = p0; w.y = p1; } else { w.z = p0; w.w = p1; }
                    }
                    unsigned char* dst = sec == 1 ? ws + WS_LF : ws + WS_QB + (size_t)(sec == 0 ? 0 : sec - 1) * (66 * MiB);
                    *(u32x4*)(dst + o * 2) = w;
                }
            }
    }
};

struct EpiUp {
    __device__ __forceinline__ bool next(int it, int nM, int nN, Unit& u) const { return unit_next(it, nM, nN, u); }
    const float* ssq; const float* cw; const float* cb; const float* hist; bf16_t* hid; float* cvp; float* cvs;
    __device__ __forceinline__ long a_row0(const Unit& u) const { return u.pm < 132 ? (long)(u.pm / 33) * SEQ + 254 * (u.pm % 33) - 2 : (long)MP + 256 * (u.pm - 132); }
    __device__ __forceinline__ int a_koff(const Unit&) const { return 0; }
    __device__ __forceinline__ void operator()(f32x4 (&acc)[2][2][4][2], const Unit& u, int wr, int wc, int fr, int fq) const {
        float* G = (float*)smem;
        const bool prompt = u.pm < 132; const int tt = u.pm % 33;
        const long rbase = a_row0(u);
        const long row_end = prompt ? (long)(u.pm / 33 + 1) * SEQ : (long)M_TOK;
        const int cl0 = wc * 32 + fq * 8, c0 = u.pn * HALF + cl0;
        f32x4 w0[2], w1[2], w2[2], bb[2];
#pragma unroll
        for (int n = 0; n < 2; ++n) { w0[n] = *(const f32x4*)(cw + c0 + 4 * n); w1[n] = *(const f32x4*)(cw + FF + c0 + 4 * n); w2[n] = *(const f32x4*)(cw + 2 * FF + c0 + 4 * n); bb[n] = *(const f32x4*)(cb + c0 + 4 * n); }
        float* rsT = (float*)(smem + LDS_RS);
        { const int t = (wr * 4 + wc) * 64 + fq * 16 + fr; if (t < 256) { long gr = rbase + t; if (gr < 0) gr = 0; rsT[t] = rstd_row(ssq + (size_t)gr * 16); } }
        __syncthreads();
#pragma unroll
        for (int ai = 0; ai < 2; ++ai)
#pragma unroll
            for (int m = 0; m < 4; ++m) {
                const int lrow = ai * HALF + wr * 64 + m * 16 + fr;
                const float rsv = rsT[lrow];
                const bool zero = prompt && tt == 0 && lrow < 2;
#pragma unroll
                for (int n = 0; n < 2; ++n) {
                    f32x4 gv = acc[ai][0][m][n] * rsv; acc[ai][1][m][n] = acc[ai][1][m][n] * rsv; if (zero) gv = (f32x4){0.f, 0.f, 0.f, 0.f};
                    acc[ai][0][m][n] = gv;
                    *(f32x4*)(G + lrow * 132 + wc * 32 + fq * 8 + n * 4) = gv;
                }
            }
        __syncthreads();
        if (prompt) {
#pragma unroll
            for (int ai = 0; ai < 2; ++ai)
#pragma unroll
                for (int m = 0; m < 4; ++m) {
                    const int lrow = ai * HALF + wr * 64 + m * 16 + fr; const long gr = rbase + lrow;
                    if (lrow >= 2 && gr < row_end) {
                        const float* Gp = G + (lrow - 2) * 132 + cl0; bf16_t* hp = hid + (size_t)gr * FF + c0; u32x4 hw;
#pragma unroll
                        for (int n = 0; n < 2; ++n) {
                            const f32x4 g2 = *(const f32x4*)(Gp + 4 * n), g1 = *(const f32x4*)(Gp + 132 + 4 * n), g0 = acc[ai][0][m][n];
                            const f32x4 cv = bb[n] + w0[n] * g2 + w1[n] * g1 + w2[n] * g0, vv = acc[ai][1][m][n];
                            f32x4 h;
#pragma unroll
                            for (int j = 0; j < 4; ++j) h[j] = cv[j] * sigmoidf_(cv[j]) * vv[j];
                            if (n == 0) { hw.x = cvt_pk_bf16(h[0], h[1]); hw.y = cvt_pk_bf16(h[2], h[3]); } else { hw.z = cvt_pk_bf16(h[0], h[1]); hw.w = cvt_pk_bf16(h[2], h[3]); }
                        }
                        *(u32x4*)hp = hw;
                        const int l = (int)(gr & (SEQ - 1));
                        if (l >= SEQ - 2) {
                            float* cp = cvp + ((size_t)(gr >> 13) * 2 + (l - (SEQ - 2))) * FF + c0;
                            *(f32x4*)cp = acc[ai][0][m][0]; *(f32x4*)(cp + 4) = acc[ai][0][m][1];
                        }
                    }
                }
        } else {
#pragma unroll
            for (int ai = 0; ai < 2; ++ai)
#pragma unroll
                for (int m = 0; m < 4; ++m) {
                    const int lrow = ai * HALF + wr * 64 + m * 16 + fr, l = lrow & 63; const long gr = rbase + lrow;
                    const int b = (int)(gr - MP) >> 6; const float* hb = hist + (size_t)b * 2 * FF + c0; bf16_t* hp = hid + (size_t)gr * FF + c0;
#pragma unroll
                    for (int n = 0; n < 2; ++n) {
                        f32x4 g1, g2; const f32x4 g0 = acc[ai][0][m][n];
                        if (l >= 2) { g1 = *(const f32x4*)(G + (lrow - 1) * 132 + cl0 + 4 * n); g2 = *(const f32x4*)(G + (lrow - 2) * 132 + cl0 + 4 * n); }
                        else if (l == 0) { g2 = *(const f32x4*)(hb + 4 * n); g1 = *(const f32x4*)(hb + FF + 4 * n); }
                        else { g2 = *(const f32x4*)(hb + FF + 4 * n); g1 = *(const f32x4*)(G + (lrow - 1) * 132 + cl0 + 4 * n); }
                        const f32x4 cv = bb[n] + w0[n] * g2 + w1[n] * g1 + w2[n] * g0, vv = acc[ai][1][m][n];
                        f32x4 h;
#pragma unroll
                        for (int j = 0; j < 4; ++j) h[j] = cv[j] * sigmoidf_(cv[j]) * vv[j];
                        u32x2 w; w.x = cvt_pk_bf16(h[0], h[1]); w.y = cvt_pk_bf16(h[2], h[3]);
                        *(u32x2*)(hp + 4 * n) = w;
                        if (l >= 62) *(f32x4*)(cvs + ((size_t)b * 2 + (l - 62)) * FF + c0 + 4 * n) = g0;
                    }
                    asm volatile("" ::: "memory");
                }
        }
    }
};


__device__ __forceinline__ void prep_tile(const float* W, int K, int N, const float* gk, bf16_t* Wt, int k0, int n0, int nd0, int wid_s) {
    bf16_t* T = (bf16_t*)smem;
    const int tid = tid_launder(wid_s), ln = tid & 31;
#pragma unroll
    for (int i = 0; i < 8; ++i) {
        const int k = i * 16 + (tid >> 5);
        f32x4 v = *(const f32x4*)(W + (size_t)(k0 + k) * N + n0 + ln * 4);
        if (gk) v = v * gk[k0 + k];
        const unsigned p0 = cvt_pk_bf16(v[0], v[1]), p1 = cvt_pk_bf16(v[2], v[3]);
        T[(0 * 32 + ln) * 130 + k] = (bf16_t)(p0 & 0xffff); T[(1 * 32 + ln) * 130 + k] = (bf16_t)(p0 >> 16);
        T[(2 * 32 + ln) * 130 + k] = (bf16_t)(p1 & 0xffff); T[(3 * 32 + ln) * 130 + k] = (bf16_t)(p1 >> 16);
    }
    __syncthreads();
#pragma unroll
    for (int i = 0; i < 4; ++i) {
        const int n = i * 32 + (tid >> 4), kq = (tid & 15) * 8;
        const unsigned* src = (const unsigned*)(T + ((n & 3) * 32 + (n >> 2)) * 130 + kq);
        u32x4 v; v.x = src[0]; v.y = src[1]; v.z = src[2]; v.w = src[3];
        *(u32x4*)(Wt + (size_t)(nd0 + n) * K + k0 + kq) = v;
    }
    __syncthreads();
}

__device__ __forceinline__ void prep_weights_layer(const Params& p, int L, int first, int stride, int wid_s) {
    unsigned char* ws = p.ws; const int j = L >> 1; const int nt = 528 + ((L & 1) ? 320 : 16);
    for (int t = first; t < nt; t += stride) {
        const float* W; const float* gk = nullptr; bf16_t* Wt; int K, N, lt, mode = 0;
        if (t < 352) { lt = t; K = DM; N = 2 * FF; W = p.in[I_WUP] + (size_t)L * DM * 2 * FF; gk = p.in[I_NFFNG] + L * DM; Wt = (bf16_t*)(ws + WS_WUP) + (size_t)L * 2 * FF * DM; mode = 1; }
        else if (t < 528) { lt = t - 352; K = FF; N = DM; W = p.in[I_WDN] + (size_t)L * FF * DM; Wt = (bf16_t*)(ws + WS_WDN) + (size_t)L * DM * FF; }
        else if (!(L & 1)) { const int mg = j * 4 + (t - 528) / 4; lt = (t - 528) % 4; K = 256; N = 256; W = p.in[I_POOLW] + (size_t)mg * 65536; Wt = (bf16_t*)(ws + WS_WPOOL) + (size_t)mg * 65536; }
        else if (t < 528 + 256) { lt = t - 528; K = DM; N = 4 * DM; W = p.in[I_HWIN] + (size_t)j * DM * 4 * DM; gk = p.in[I_NMIXG] + L * DM; Wt = (bf16_t*)(ws + WS_WIN) + (size_t)j * 4 * DM * DM; }
        else { lt = t - 784; K = DM; N = DM; W = p.in[I_HWOUT] + (size_t)j * DM * DM; Wt = (bf16_t*)(ws + WS_WOUT) + (size_t)j * DM * DM; }
        const int nkb = K / 128, kb = lt % nkb, nb = lt / nkb;
        int nd0 = nb * 128; if (mode == 1) nd0 = nb < 22 ? nb * 256 : (nb - 22) * 256 + 128;
        prep_tile(W, K, N, gk, Wt, kb * 128, nb * 128, nd0, wid_s);
    }
}

__device__ __forceinline__ void phase_prep(const Params& p, int wid_s) {
    unsigned char* ws = p.ws;
    prep_weights_layer(p, 0, blockIdx.x, gridDim.x, wid_s);
    const int tidp = tid_launder(wid_s); const int gtid = blockIdx.x * blockDim.x + tidp, gsz = gridDim.x * blockDim.x;
    for (int c = gtid; c < DM; c += gsz) {
        const float* lg = p.in[I_LBLOG]; float a0 = lg[c], a1 = lg[DM + c], a2 = lg[2 * DM + c], a3 = lg[3 * DM + c];
        const float mx = fmaxf(fmaxf(a0, a1), fmaxf(a2, a3)); a0 = expf(a0 - mx); a1 = expf(a1 - mx); a2 = expf(a2 - mx); a3 = expf(a3 - mx);
        const float inv = 1.0f / (a0 + a1 + a2 + a3); float* lb = (float*)(ws + WS_LB);
        lb[c] = 0.f; lb[DM + c] = a1 * inv; lb[2 * DM + c] = (a1 + a2) * inv; lb[3 * DM + c] = (a1 + a2 + a3) * inv;
    }
    const int wv = gtid >> 6, nwv = gsz >> 6, lane = tidp & 63;
    bf16_t* xb = (bf16_t*)(ws + WS_XB); float* ssq0 = (float*)(ws + WS_SSQP);
    for (int row = wv; row < M_TOK; row += nwv) {
        const float* xr = row < MP ? p.in[I_XP] + (size_t)row * DM : p.in[I_XS] + (size_t)(row - MP) * DM;
        float ss = 0.f;
#pragma unroll
        for (int i = 0; i < 4; ++i) {
            const f32x4 v = *(const f32x4*)(xr + i * 256 + lane * 4);
            ss += (v[0] * v[0] + v[1] * v[1]) + (v[2] * v[2] + v[3] * v[3]);
            u32x2 w; w.x = cvt_pk_bf16(v[0], v[1]); w.y = cvt_pk_bf16(v[2], v[3]);
            *(u32x2*)(xb + (size_t)row * DM + i * 256 + lane * 4) = w;
        }
#pragma unroll
        for (int o = 32; o >= 1; o >>= 1) ss += __shfl_xor(ss, o);
        if (lane < 16) ssq0[(size_t)row * 16 + lane] = lane == 0 ? ss : 0.f;
    }
}

template <int WIN>
__device__ __forceinline__ void pool_walk(const Params& p, int L, int sgi, const float* rsT, int tid) {
    const int  c0 = tid * 2, j = L >> 1;
    const int R0 = sgi * 64; const bool prompt = R0 < MP;
    const int b = prompt ? R0 >> 13 : (R0 - MP) >> 6, l0 = prompt ? (R0 & (SEQ - 1)) : 0, Lseq = prompt ? SEQ : DSEQ;
    const bf16_t* xb = (const bf16_t*)(p.ws + WS_XB); bf16_t* dbuf = (bf16_t*)(p.ws + WS_DBUF);
    const f32x2 g2 = *(const f32x2*)(p.in[I_NMIXG] + L * DM + c0);
    const float* hist = p.in[I_SPOOL] + ((size_t)j * 16 + b) * 15 * DM + c0;
    float* outp = prompt ? p.out + O_POOLP + ((size_t)j * 4 + b) * 15 * DM + c0 : p.out + O_POOLS + ((size_t)j * 16 + b) * 15 * DM + c0;
    unsigned raw[79]; f32x2 hv[15];
    const bool warm = l0 >= 15;
    const bf16_t* xp = xb + (size_t)(R0 - 15) * DM + c0;
#pragma unroll
    for (int i = 15; i < 79; ++i) raw[i] = *(const unsigned*)(xp + (size_t)i * DM);
    if (warm) {
#pragma unroll
        for (int i = 0; i < 15; ++i) raw[i] = *(const unsigned*)(xp + (size_t)i * DM);
    } else {
#pragma unroll
        for (int i = 0; i < 15; ++i) raw[i] = 0u;
    }
    if (!prompt) {
#pragma unroll
        for (int i = 0; i < 15; ++i) hv[i] = *(const f32x2*)(hist + (size_t)i * DM);
    } else {
#pragma unroll
        for (int i = 0; i < 15; ++i) hv[i] = (f32x2){0.f, 0.f};
    }
    float r0[16], r1[16]; float s0 = 0.f, s1 = 0.f;
#pragma unroll
    for (int k = 0; k < 16; ++k) { r0[k] = 0.f; r1[k] = 0.f; }
#pragma unroll
    for (int i = 0; i < 79; ++i) {
        const int k = i & 15, li = l0 - 15 + i;
        float h0, h1;
        if (i >= 15 || warm) { const float rs = rsT[i]; h0 = bf_lo(raw[i]) * rs * g2.x; h1 = bf_hi(raw[i]) * rs * g2.y; }
        else { h0 = hv[i < 15 ? i : 0].x; h1 = hv[i < 15 ? i : 0].y; }
        s0 += h0 - r0[(k - WIN) & 15]; s1 += h1 - r1[(k - WIN) & 15];
        r0[k] = h0; r1[k] = h1;
        if (i >= 15) {
            const int cnt = prompt ? (li + 1 < WIN ? li + 1 : WIN) : WIN; const float inv = 1.0f / (float)cnt;
            *(unsigned*)(dbuf + (size_t)(R0 + i - 15) * DM + c0) = cvt_pk_bf16(s0 * inv - h0, s1 * inv - h1);
            if (li >= Lseq - 15) *(f32x2*)(outp + (size_t)(li - (Lseq - 15)) * DM) = (f32x2){h0, h1};
        }
    }
}
__device__ __forceinline__ void phase_pool_d(const Params& p, int L, int wid_s) {
    float* rsT = (float*)smem; const float* ssq = (const float*)(p.ws + WS_SSQP) + (size_t)(2 * L) * SSQ_STRIDE;
    const int tid = tid_launder(wid_s);
    for (int sgi = blockIdx.x; sgi < M_TOK / 64; sgi += gridDim.x) {
        const int R0 = sgi * 64;
        __syncthreads();
        if (tid < 79) { const int r = R0 - 15 + tid; rsT[tid] = rstd_row(ssq + (size_t)(r < 0 ? 0 : r) * 16); }
        __syncthreads();
        switch (tid >> 7) { case 0: pool_walk<2>(p, L, sgi, rsT, tid); break; case 1: pool_walk<4>(p, L, sgi, rsT, tid); break; case 2: pool_walk<8>(p, L, sgi, rsT, tid); break; default: pool_walk<16>(p, L, sgi, rsT, tid); break; }
    }
}

struct ChunkB { float lf[4][4]; float b[4][4]; float bref[4]; float bC[4]; };
__device__ __forceinline__ void lds_barrier() { asm volatile("s_waitcnt lgkmcnt(0)" ::: "memory"); __builtin_amdgcn_s_barrier(); asm volatile("" ::: "memory"); }
struct ChunkRaw { u32x2 lf[4]; };
__device__ __forceinline__ void chunk_load_lf(const _Float16* lfp, ChunkRaw& r, int tid) {
    const int cg = tid & 31, rg = tid >> 5;
#pragma unroll
    for (int i = 0; i < 4; ++i) r.lf[i] = *(const u32x2*)(lfp + (size_t)(4 * rg + i) * DM + 4 * cg);
}
__device__ __forceinline__ void chunk_cumsum(const ChunkRaw& r, ChunkB& cb, float* T  , int tid) {
    const int cg = tid & 31, rg = tid >> 5;
#pragma unroll
    for (int i = 0; i < 4; ++i) { const h16x4 h = __builtin_bit_cast(h16x4, r.lf[i]);
#pragma unroll
        for (int j = 0; j < 4; ++j) cb.lf[i][j] = (float)h[j]; }
#pragma unroll
    for (int j = 0; j < 4; ++j) { cb.b[0][j] = cb.lf[0][j]; cb.b[1][j] = cb.b[0][j] + cb.lf[1][j]; cb.b[2][j] = cb.b[1][j] + cb.lf[2][j]; cb.b[3][j] = cb.b[2][j] + cb.lf[3][j]; }
    *(f32x4*)(T + rg * 128 + 4 * cg) = (f32x4){cb.b[3][0], cb.b[3][1], cb.b[3][2], cb.b[3][3]};
    lds_barrier();
    f32x4 off = {0.f, 0.f, 0.f, 0.f}, br = {0.f, 0.f, 0.f, 0.f}, bc = {0.f, 0.f, 0.f, 0.f};
#pragma unroll
    for (int r2 = 0; r2 < 16; ++r2) { const f32x4 t = *(const f32x4*)(T + r2 * 128 + 4 * cg); if (r2 < rg) off = off + t; if (r2 < 8) br = br + t; bc = bc + t; }
#pragma unroll
    for (int j = 0; j < 4; ++j) { cb.bref[j] = br[j]; cb.bC[j] = bc[j];
#pragma unroll
        for (int i = 0; i < 4; ++i) cb.b[i][j] += off[j]; }
}

__device__ __forceinline__ void phase_hds(const Params& p, int wid_s) {
    unsigned char* ws = p.ws;
    float* T = (float*)smem;
    unsigned char* KdT = smem + 8192;
    unsigned char* Vt = KdT + 128 * 144;
    const _Float16* lf = (const _Float16*)(ws + WS_LF); const bf16_t* vb = (const bf16_t*)(ws + WS_VB);
    bf16_t* dS = (bf16_t*)(p.out + O_Y); float* dc = (float*)(ws + WS_DC);
    const int tid = tid_launder(wid_s), cg = tid & 31, rg = tid >> 5, wid = tid >> 6, lane = tid & 63, fr = lane & 15, fq = lane >> 4;
    ChunkRaw nraw; u32x2 nv[4];
    { const int u0 = blockIdx.x; if (u0 < 4224) { const size_t org0 = (size_t)(u0 >> 3) * 64 * DM + (u0 & 7) * 128; chunk_load_lf(lf + org0, nraw, tid);
#pragma unroll
        for (int i = 0; i < 4; ++i) nv[i] = *(const u32x2*)(vb + org0 + (size_t)(4 * rg + i) * DM + 4 * cg); } }
    for (int u = blockIdx.x; u < 4224; u += gridDim.x) {
        const ChunkRaw raw = nraw; u32x2 cv[4];
#pragma unroll
        for (int i = 0; i < 4; ++i) cv[i] = nv[i];
        { const int un = u + (int)gridDim.x; if (un < 4224) { const size_t orgn = (size_t)(un >> 3) * 64 * DM + (un & 7) * 128; chunk_load_lf(lf + orgn, nraw, tid);
#pragma unroll
            for (int i = 0; i < 4; ++i) nv[i] = *(const u32x2*)(vb + orgn + (size_t)(4 * rg + i) * DM + 4 * cg); } }
        lds_barrier();
        ChunkB cb; chunk_cumsum(raw, cb, T, tid);
        float kd[4][4]; unsigned vw[4][2];
#pragma unroll
        for (int i = 0; i < 4; ++i) { const u32x2 w = cv[i]; vw[i][0] = w.x; vw[i][1] = w.y;
#pragma unroll
            for (int j = 0; j < 4; ++j) kd[i][j] = (1.0f - fexp(cb.lf[i][j])) * fexp(cb.bC[j] - cb.b[i][j]); }
#pragma unroll
        for (int j = 0; j < 4; ++j) {
            u32x2 w; w.x = cvt_pk_bf16(kd[0][j], kd[1][j]); w.y = cvt_pk_bf16(kd[2][j], kd[3][j]);
            *(u32x2*)(KdT + (4 * cg + j) * 144 + rg * 8) = w;
            unsigned short e[4];
#pragma unroll
            for (int i = 0; i < 4; ++i) e[i] = (unsigned short)((j & 1) ? (vw[i][j >> 1] >> 16) : (vw[i][j >> 1] & 0xffff));
            u32x2 x; x.x = (unsigned)e[0] | ((unsigned)e[1] << 16); x.y = (unsigned)e[2] | ((unsigned)e[3] << 16);
            *(u32x2*)(Vt + (4 * cg + j) * 144 + rg * 8) = x;
        }
        if (rg == 0) *(f32x4*)(dc + (size_t)u * 128 + 4 * cg) = (f32x4){fexp(cb.bC[0]), fexp(cb.bC[1]), fexp(cb.bC[2]), fexp(cb.bC[3])};
        lds_barrier();
        bf16x8 bv[2]; u32x2 hold = {0u, 0u};
#pragma unroll
        for (int ks = 0; ks < 2; ++ks) bv[ks] = *(const bf16x8*)(Vt + (wid * 16 + fr) * 144 + ks * 64 + fq * 16);
#pragma unroll
        for (int kb = 0; kb < 8; ++kb) {
            f32x4 a = {0.f, 0.f, 0.f, 0.f};
#pragma unroll
            for (int ks = 0; ks < 2; ++ks) { const bf16x8 af = *(const bf16x8*)(KdT + ((fr >> 2) * 32 + kb * 4 + (fr & 3)) * 144 + ks * 64 + fq * 16); a = __builtin_amdgcn_mfma_f32_16x16x32_bf16(af, bv[ks], a, 0, 0, 0); }
            if (kb & 1) { u32x4 w; w.x = hold.x; w.y = hold.y; w.z = cvt_pk_bf16(a[0], a[1]); w.w = cvt_pk_bf16(a[2], a[3]);
                *(u32x4*)(dS + ((size_t)u * 128 + wid * 16 + fr) * 128 + fq * 32 + (kb - 1) * 4) = w; }
            else { hold.x = cvt_pk_bf16(a[0], a[1]); hold.y = cvt_pk_bf16(a[2], a[3]); }
        }
    }
}

__device__ __forceinline__ void phase_hscan(const Params& p, int L, int wid_s) {
    unsigned char* ws = p.ws; const int j = L >> 1;
    bf16_t* dS = (bf16_t*)(p.out + O_Y); const float* dc = (const float*)(ws + WS_DC);
    const int gtid = blockIdx.x * blockDim.x + tid_launder(wid_s), gsz = gridDim.x * blockDim.x;
    for (int task = gtid; task < 32 * 4096; task += gsz) {
        const int kq = task & 31, v = (task >> 5) & 127, bh = task >> 12, b = bh >> 3, h = bh & 7;
        f32x4 S = {0.f, 0.f, 0.f, 0.f};
        const size_t ustride = (size_t)8 * 16384; bf16_t* ptr = dS + ((size_t)(b * 128) * 8 + h) * 16384 + v * 128 + kq * 4;
        const float* dptr = dc + ((size_t)(b * 128) * 8 + h) * 128 + kq * 4;
        u32x2 w[8]; f32x4 d[8];
#pragma unroll
        for (int i = 0; i < 8; ++i) { w[i] = *(const u32x2*)(ptr + i * ustride); d[i] = *(const f32x4*)(dptr + (size_t)i * 8 * 128); }
        for (int c0 = 0; c0 < 128; c0 += 8) {
            u32x2 wn[8]; f32x4 dn[8];
            if (c0 + 8 < 128) {
#pragma unroll
                for (int i = 0; i < 8; ++i) { wn[i] = *(const u32x2*)(ptr + (size_t)(c0 + 8 + i) * ustride); dn[i] = *(const f32x4*)(dptr + (size_t)(c0 + 8 + i) * 8 * 128); }
            } else {
#pragma unroll
                for (int i = 0; i < 8; ++i) { wn[i] = (u32x2){0u, 0u}; dn[i] = (f32x4){0.f, 0.f, 0.f, 0.f}; }
            }
#pragma unroll
            for (int i = 0; i < 8; ++i) {
                u32x2 o; o.x = cvt_pk_bf16(S[0], S[1]); o.y = cvt_pk_bf16(S[2], S[3]);
#ifndef DIAG_NOSTORE
                *(u32x2*)(ptr + (size_t)(c0 + i) * ustride) = o;
#endif
                const f32x4 ds = {bf_lo(w[i].x), bf_hi(w[i].x), bf_lo(w[i].y), bf_hi(w[i].y)};
                S = d[i] * S + ds;
            }
#pragma unroll
            for (int i = 0; i < 8; ++i) { w[i] = wn[i]; d[i] = dn[i]; }
        }
        float* o = p.out + O_HGP + (((size_t)j * 4 + b) * 8 + h) * 16384 + (size_t)(kq * 4) * 128 + v;
        o[0] = S[0]; o[128] = S[1]; o[256] = S[2]; o[384] = S[3];
    }
#ifndef NO_SAMPLE_SCAN
    for (int task = gtid; task < 128 * 4096; task += gsz) {
        const int vq = task & 31, k = (task >> 5) & 127, bh = task >> 12, b = bh >> 3, h = bh & 7;
        const int u = (512 + b) * 8 + h;
        const size_t so = (((size_t)j * 16 + b) * 8 + h) * 16384 + (size_t)k * 128 + vq * 4;
        const f32x4 S0 = *(const f32x4*)(p.in[I_SHG] + so);
        const float dk = dc[(size_t)u * 128 + k];
        bf16_t* ptr = dS + (size_t)u * 16384 + (size_t)(vq * 4) * 128 + k;
        f32x4 Sf;
#pragma unroll
        for (int i = 0; i < 4; ++i) { const float ds = __uint_as_float((unsigned)ptr[i * 128] << 16); Sf[i] = dk * S0[i] + ds; ptr[i * 128] = (bf16_t)(cvt_pk_bf16(S0[i], 0.f) & 0xffff); }
        *(f32x4*)(p.out + O_HGS + so) = Sf;
    }
#endif
}

__device__ __forceinline__ void phase_hout(const Params& p, int L, int wid_s) {
    unsigned char* ws = p.ws; const int jj = L >> 1;
    float* T = (float*)smem;
    unsigned char* Q1 = smem + 8192;
    unsigned char* Q2 = Q1 + 64 * 272;
    unsigned char* K1 = Q2 + 64 * 272;
    unsigned char* Vt = K1 + 64 * 272;
    unsigned char* St = Vt + 128 * 144;
    unsigned char* Ab = St + 128 * 272;
    float* red = (float*)(Ab + 64 * 144);
    const _Float16* lf = (const _Float16*)(ws + WS_LF); const bf16_t* vb = (const bf16_t*)(ws + WS_VB); const bf16_t* gb = (const bf16_t*)(ws + WS_GB);
    bf16_t* qb = (bf16_t*)(ws + WS_QB); const bf16_t* Sc = (const bf16_t*)(p.out + O_Y);
    const float* gn = p.in[I_HNORMG] + jj * DM;
    const int tid = tid_launder(wid_s), cg = tid & 31, rg = tid >> 5, wid = tid >> 6, lane = tid & 63, fr = lane & 15, fq = lane >> 4;
    ChunkRaw nraw; u32x2 nq[4], nv[4]; u32x4 ns[4];
#define HOUT_LOAD(uu) do { const size_t org_ = (size_t)((uu) >> 3) * 64 * DM + ((uu) & 7) * 128; chunk_load_lf(lf + org_, nraw, tid); \
        _Pragma("unroll") for (int i = 0; i < 4; ++i) { const size_t o_ = org_ + (size_t)(4 * rg + i) * DM + 4 * cg; nq[i] = *(const u32x2*)(qb + o_); nv[i] = *(const u32x2*)(vb + o_); \
            const int idx_ = tid + 512 * i; ns[i] = *(const u32x4*)(Sc + (size_t)(uu) * 16384 + (idx_ >> 4) * 128 + (idx_ & 15) * 8); } } while (0)
    if ((int)blockIdx.x < 4224) HOUT_LOAD((int)blockIdx.x);
    for (int u = blockIdx.x; u < 4224; u += gridDim.x) {
        const int c = u >> 3, h = u & 7; const size_t org = (size_t)c * 64 * DM + h * 128;
        const ChunkRaw raw = nraw; u32x2 cq[4], cv[4]; u32x4 cs[4];
#pragma unroll
        for (int i = 0; i < 4; ++i) { cq[i] = nq[i]; cv[i] = nv[i]; cs[i] = ns[i]; }
        lds_barrier();
        ChunkB cb; chunk_cumsum(raw, cb, T, tid);
#pragma unroll
        for (int i = 0; i < 4; ++i) { const int idx = tid + 512 * i, r = idx >> 4, c8 = (idx & 15) * 8; *(u32x4*)(St + r * 272 + c8 * 2) = cs[i]; }
        unsigned vw[4][2];
#pragma unroll
        for (int i = 0; i < 4; ++i) {
            const u32x2 qw = cq[i]; const u32x2 w = cv[i]; vw[i][0] = w.x; vw[i][1] = w.y;
            const float q[4] = {bf_lo(qw.x), bf_hi(qw.x), bf_lo(qw.y), bf_hi(qw.y)};
            float q1[4], q2[4], k1[4];
#pragma unroll
            for (int j = 0; j < 4; ++j) { const float kk = 1.0f - fexp(cb.lf[i][j]); q1[j] = q[j] * fexp(cb.b[i][j] - cb.bref[j]); q2[j] = q[j] * fexp(cb.b[i][j]); k1[j] = kk * fexp(cb.bref[j] - cb.b[i][j]); }
            u32x2 a; a.x = cvt_pk_bf16(q1[0], q1[1]); a.y = cvt_pk_bf16(q1[2], q1[3]); *(u32x2*)(Q1 + (4 * rg + i) * 272 + cg * 8) = a;
            a.x = cvt_pk_bf16(q2[0], q2[1]); a.y = cvt_pk_bf16(q2[2], q2[3]); *(u32x2*)(Q2 + (4 * rg + i) * 272 + cg * 8) = a;
            a.x = cvt_pk_bf16(k1[0], k1[1]); a.y = cvt_pk_bf16(k1[2], k1[3]); *(u32x2*)(K1 + (4 * rg + i) * 272 + cg * 8) = a;
        }
#pragma unroll
        for (int j = 0; j < 4; ++j) {
            unsigned short e[4];
#pragma unroll
            for (int i = 0; i < 4; ++i) e[i] = (unsigned short)((j & 1) ? (vw[i][j >> 1] >> 16) : (vw[i][j >> 1] & 0xffff));
            u32x2 x; x.x = (unsigned)e[0] | ((unsigned)e[1] << 16); x.y = (unsigned)e[2] | ((unsigned)e[3] << 16);
            *(u32x2*)(Vt + (4 * cg + j) * 144 + rg * 8) = x;
        }
        lds_barrier();
        const int tb = wid & 3, hv = wid >> 2;
        const size_t orow = org + (size_t)(tb * 16 + fr) * DM;
        u32x4 gw8[2];
#pragma unroll
        for (int q = 0; q < 2; ++q) gw8[q] = *(const u32x4*)(gb + orow + hv * 64 + fq * 16 + q * 8);
        { const int un = u + (int)gridDim.x; if (un < 4224) HOUT_LOAD(un); }
#pragma unroll
        for (int q = 0; q < 2; ++q) {
            const int sb = hv * 2 + q; f32x4 a = {0.f, 0.f, 0.f, 0.f};
            if (sb <= tb) {
#pragma unroll
                for (int ks = 0; ks < 4; ++ks) { const bf16x8 af = *(const bf16x8*)(K1 + (sb * 16 + fr) * 272 + ks * 64 + fq * 16); const bf16x8 bf = *(const bf16x8*)(Q1 + (tb * 16 + fr) * 272 + ks * 64 + fq * 16);
                    a = __builtin_amdgcn_mfma_f32_16x16x32_bf16(af, bf, a, 0, 0, 0); }
#pragma unroll
                for (int r = 0; r < 4; ++r) if (sb * 16 + fq * 4 + r > tb * 16 + fr) a[r] = 0.f;
            }
            u32x2 w; w.x = cvt_pk_bf16(a[0], a[1]); w.y = cvt_pk_bf16(a[2], a[3]);
            *(u32x2*)(Ab + (tb * 16 + fr) * 144 + sb * 32 + fq * 8) = w;
        }
        f32x4 o4[4];
#pragma unroll
        for (int vi = 0; vi < 4; ++vi) o4[vi] = (f32x4){0.f, 0.f, 0.f, 0.f};
#pragma unroll
        for (int ks = 0; ks < 4; ++ks) { const bf16x8 bf = *(const bf16x8*)(Q2 + (tb * 16 + fr) * 272 + ks * 64 + fq * 16);
#pragma unroll
            for (int vi = 0; vi < 4; ++vi) { const bf16x8 af = *(const bf16x8*)(St + (hv * 64 + (fr >> 2) * 16 + vi * 4 + (fr & 3)) * 272 + ks * 64 + fq * 16); o4[vi] = __builtin_amdgcn_mfma_f32_16x16x32_bf16(af, bf, o4[vi], 0, 0, 0); } }
        lds_barrier();
#pragma unroll
        for (int ks = 0; ks < 2; ++ks) { const bf16x8 bf = *(const bf16x8*)(Ab + (tb * 16 + fr) * 144 + ks * 64 + fq * 16);
#pragma unroll
            for (int vi = 0; vi < 4; ++vi) { const bf16x8 af = *(const bf16x8*)(Vt + (hv * 64 + (fr >> 2) * 16 + vi * 4 + (fr & 3)) * 144 + ks * 64 + fq * 16); o4[vi] = __builtin_amdgcn_mfma_f32_16x16x32_bf16(af, bf, o4[vi], 0, 0, 0); } }
        float ss = 0.f;
#pragma unroll
        for (int vi = 0; vi < 4; ++vi) ss += (o4[vi][0] * o4[vi][0] + o4[vi][1] * o4[vi][1]) + (o4[vi][2] * o4[vi][2] + o4[vi][3] * o4[vi][3]);
        ss += __shfl_xor(ss, 16); ss += __shfl_xor(ss, 32);
        if (fq == 0) red[hv * 64 + tb * 16 + fr] = ss;
        lds_barrier();
        const float rs = rsqrtf((red[tb * 16 + fr] + red[64 + tb * 16 + fr]) * (1.0f / 128.0f) + EPS);
        u32x2 ow[4];
#pragma unroll
        for (int vi = 0; vi < 4; ++vi) {
            const int vc = hv * 64 + fq * 16 + vi * 4;
            const f32x4 g4 = *(const f32x4*)(gn + h * 128 + vc);
            const unsigned glo = (vi & 1) ? gw8[vi >> 1].z : gw8[vi >> 1].x, ghi = (vi & 1) ? gw8[vi >> 1].w : gw8[vi >> 1].y;
            const float r0 = o4[vi][0] * rs * g4[0] * bf_lo(glo), r1 = o4[vi][1] * rs * g4[1] * bf_hi(glo), r2 = o4[vi][2] * rs * g4[2] * bf_lo(ghi), r3 = o4[vi][3] * rs * g4[3] * bf_hi(ghi);
            ow[vi].x = cvt_pk_bf16(r0, r1); ow[vi].y = cvt_pk_bf16(r2, r3);
        }
#pragma unroll
        for (int q = 0; q < 2; ++q) { u32x4 w; w.x = ow[2 * q].x; w.y = ow[2 * q].y; w.z = ow[2 * q + 1].x; w.w = ow[2 * q + 1].y; *(u32x4*)(qb + orow + hv * 64 + fq * 16 + q * 8) = w; }
    }
}

__device__ __forceinline__ void phase_final(const Params& p, int wid_s) {
    const int tidf = tid_launder(wid_s); const int gtid = blockIdx.x * blockDim.x + tidf, gsz = gridDim.x * blockDim.x, wv = gtid >> 6, nwv = gsz >> 6, lane = tidf & 63;
    const float* ssq = (const float*)(p.ws + WS_SSQP) + (size_t)8 * SSQ_STRIDE; const float* g = p.in[I_NOUTG]; const bf16_t* xb = (const bf16_t*)(p.ws + WS_XB);
    for (int row = wv; row < M_TOK; row += 2 * nwv) {
        const int row2 = row + nwv; const bool has2 = row2 < M_TOK; const int r2 = has2 ? row2 : row;
        u32x4 a[2], b2[2];
#pragma unroll
        for (int i = 0; i < 2; ++i) { a[i] = *(const u32x4*)(xb + (size_t)row * DM + i * 512 + lane * 8); b2[i] = *(const u32x4*)(xb + (size_t)r2 * DM + i * 512 + lane * 8); }
        const float rs = rstd_row(ssq + (size_t)row * 16), rs2 = rstd_row(ssq + (size_t)r2 * 16);
#pragma unroll
        for (int i = 0; i < 2; ++i) {
            const int c = i * 512 + lane * 8; const f32x4 g0 = *(const f32x4*)(g + c), g1 = *(const f32x4*)(g + c + 4);
            float* y = p.out + O_Y + (size_t)row * DM + c;
            *(f32x4*)y = (f32x4){bf_lo(a[i].x), bf_hi(a[i].x), bf_lo(a[i].y), bf_hi(a[i].y)} * rs * g0; *(f32x4*)(y + 4) = (f32x4){bf_lo(a[i].z), bf_hi(a[i].z), bf_lo(a[i].w), bf_hi(a[i].w)} * rs * g1;
            if (has2) { float* y2 = p.out + O_Y + (size_t)row2 * DM + c;
                *(f32x4*)y2 = (f32x4){bf_lo(b2[i].x), bf_hi(b2[i].x), bf_lo(b2[i].y), bf_hi(b2[i].y)} * rs2 * g0; *(f32x4*)(y2 + 4) = (f32x4){bf_lo(b2[i].z), bf_hi(b2[i].z), bf_lo(b2[i].w), bf_hi(b2[i].w)} * rs2 * g1; }
        }
    }
}

constexpr size_t WS_BAR = 2 * MiB + 512 * 1024;
#define XB_CENSUS(j) (64 * (1 + (j)))
#define XB_SUB(j) (64 * (17 + (j)))
#define XB_XGEN(j) (64 * (33 + (j)))
#define XB_TOP (64 * 49)
#define XB_TOPGEN (64 * 50)
constexpr size_t XB_BYTES = 64 * 51 * 4;
__device__ __forceinline__ unsigned xb_ld(unsigned* p) { return __hip_atomic_load(p, __ATOMIC_RELAXED, __HIP_MEMORY_SCOPE_AGENT); }
__device__ __forceinline__ unsigned xb_add(unsigned* p, unsigned v) { return __hip_atomic_fetch_add(p, v, __ATOMIC_RELAXED, __HIP_MEMORY_SCOPE_AGENT); }
struct XBar { unsigned* bar; unsigned x, nloc, nx; };
__device__ __forceinline__ void grid_barrier(const XBar& b, int wid_s) {
    asm volatile("s_waitcnt vmcnt(0) lgkmcnt(0)" ::: "memory");
    __syncthreads();
    if (wid_s == 0) {
        if (tid_launder(wid_s) == 0) {
            const unsigned old = xb_add(&b.bar[XB_SUB(b.x)], 1u), gen = old / b.nloc;
            if (old + 1u == (gen + 1u) * b.nloc) {
                __builtin_amdgcn_fence(__ATOMIC_RELEASE, "agent");
                asm volatile("s_waitcnt vmcnt(0)" ::: "memory");
                const unsigned og = xb_add(&b.bar[XB_TOP], 1u), tg = og / b.nx;
                if (og + 1u == (tg + 1u) * b.nx) xb_add(&b.bar[XB_TOPGEN], 1u);
                else while (xb_ld(&b.bar[XB_TOPGEN]) == tg) __builtin_amdgcn_s_sleep(1);
                xb_add(&b.bar[XB_XGEN(b.x)], 1u);
            } else while (xb_ld(&b.bar[XB_XGEN(b.x)]) == gen) __builtin_amdgcn_s_sleep(1);
        }
        __builtin_amdgcn_fence(__ATOMIC_ACQUIRE, "agent");
        asm volatile("s_waitcnt vmcnt(0)" ::: "memory");
    }
    __syncthreads();
}

enum { OP_PREP = 0, OP_POOLD, OP_POOLG, OP_HIN, OP_HDS, OP_HSCAN, OP_HOUT, OP_HPROJ, OP_UP, OP_DOWN, OP_FINAL };
constexpr int NPH = 24;
__device__ __forceinline__ void phase_decode(int ph, int& op, int& L) {
    if (ph == 0) { op = OP_PREP; L = 0; return; }
    if (ph == 23) { op = OP_FINAL; L = 0; return; }
    int q = ph - 1;
    const int pr = q / 11; q %= 11;
    if (q < 4) { L = 2 * pr; op = q == 0 ? OP_POOLD : q == 1 ? OP_POOLG : q == 2 ? OP_UP : OP_DOWN; }
    else { q -= 4; L = 2 * pr + 1; op = q == 0 ? OP_HIN : q == 1 ? OP_HDS : q == 2 ? OP_HSCAN : q == 3 ? OP_HOUT : q == 4 ? OP_HPROJ : q == 5 ? OP_UP : OP_DOWN; }
}

template <int MASK>
__device__ __forceinline__ void run_op(const Params& p, int op, int L, int wid_s, unsigned long long* tk = nullptr, bool coop = false) {
    unsigned char* ws = p.ws;
    float* xf = p.out + O_Y; bf16_t* xb = (bf16_t*)(ws + WS_XB); float* ssq = (float*)(ws + WS_SSQP);
#define PHON(x) if (!((MASK >> (x)) & 1)) break;
    switch (op) {
    case OP_PREP: PHON(OP_PREP) phase_prep(p, wid_s); break;
    case OP_POOLD: PHON(OP_POOLD) phase_pool_d(p, L, wid_s); break;
    case OP_HDS: PHON(OP_HDS) phase_hds(p, wid_s); break;
    case OP_HSCAN: PHON(OP_HSCAN) phase_hscan(p, L, wid_s); break;
    case OP_HOUT: PHON(OP_HOUT) phase_hout(p, L, wid_s); break;
    case OP_FINAL: PHON(OP_FINAL) phase_final(p, wid_s); break;
    case OP_POOLG: case OP_HPROJ: case OP_DOWN: { PHON(OP_DOWN)
        GemmArgs g; EpiResid e; e.xf = xf; e.xb = xb; e.xin_p = nullptr; e.xin_s = nullptr; e.colscale = nullptr; e.koff_per_pn = 0; e.flags = nullptr;
        g.nM = M_TOK / BM; g.nN = DM / BM;
        if (op == OP_POOLG) { g.A = (const bf16_t*)(ws + WS_DBUF); g.lda = DM; g.K = 256; g.Bt = (const bf16_t*)(ws + WS_WPOOL) + (size_t)(L >> 1) * 4 * 65536; g.ldb = 256;
            e.colscale = p.in[I_POOLSC] + (L >> 1) * DM; e.koff_per_pn = 256; e.ssq = ssq + (size_t)(2 * L + 1) * SSQ_STRIDE;
            if (L == 0) { e.xin_p = p.in[I_XP]; e.xin_s = p.in[I_XS]; } }
        else if (op == OP_HPROJ) { g.A = (const bf16_t*)(ws + WS_QB); g.lda = DM; g.K = DM; g.Bt = (const bf16_t*)(ws + WS_WOUT) + (size_t)(L >> 1) * DM * DM; g.ldb = DM; e.ssq = ssq + (size_t)(2 * L + 1) * SSQ_STRIDE; }
        else { g.A = (const bf16_t*)(ws + WS_HID); g.lda = FF; g.K = FF; g.Bt = (const bf16_t*)(ws + WS_WDN) + (size_t)L * DM * FF; g.ldb = FF; e.ssq = ssq + (size_t)(2 * L + 2) * SSQ_STRIDE;
            if (coop && gridDim.x == 256) e.flags = (unsigned*)(ws + WS_BAR + XB_BYTES) + L * 16; }
        gemm_phase(g, e, wid_s, tk);
        if (op == OP_DOWN && L < 3) {
            const int nwg3 = e.flags ? 32 : 528 - 2 * (int)gridDim.x;
            if (nwg3 > 0 && (int)blockIdx.x >= nwg3) prep_weights_layer(p, L + 1, (int)blockIdx.x - nwg3, (int)gridDim.x - nwg3, wid_s);
            else if (nwg3 <= 0) prep_weights_layer(p, L + 1, (int)blockIdx.x, (int)gridDim.x, wid_s);
        }
    } break;
    case OP_HIN: { PHON(OP_HIN)
        GemmArgs g; g.A = xb; g.lda = DM; g.K = DM; g.Bt = (const bf16_t*)(ws + WS_WIN) + (size_t)(L >> 1) * 4 * DM * DM; g.ldb = DM; g.nM = M_TOK / BM; g.nN = 4 * DM / BM;
        EpiHin e; e.ssq = ssq + (size_t)(2 * L) * SSQ_STRIDE; e.lb = (const float*)(ws + WS_LB) + L * DM; e.ws = ws;
        gemm_phase(g, e, wid_s, tk);
    } break;
    case OP_UP: { PHON(OP_UP)
        GemmArgs g; g.A = xb; g.lda = DM; g.K = DM; g.Bt = (const bf16_t*)(ws + WS_WUP) + (size_t)L * 2 * FF * DM; g.ldb = DM; g.nM = 136; g.nN = 2 * FF / BM;
        EpiUp e; e.ssq = ssq + (size_t)(2 * L + 1) * SSQ_STRIDE; e.cw = p.in[I_CONVW] + (size_t)L * 3 * FF; e.cb = p.in[I_CONVB] + (size_t)L * FF; e.hist = p.in[I_SCONV] + (size_t)L * 16 * 2 * FF;
        e.hid = (bf16_t*)(ws + WS_HID); e.cvp = p.out + O_CVP + (size_t)L * 4 * 2 * FF; e.cvs = p.out + O_CVS + (size_t)L * 16 * 2 * FF;
        gemm_phase(g, e, wid_s, tk);
    } break;
    }
#undef PHON
}

__global__ void __launch_bounds__(512, 2) mega(Params p, int ph_lo, int ph_hi) {
    const int wid_s = __builtin_amdgcn_readfirstlane((int)(threadIdx.x >> 6));
    XBar xb; xb.bar = (unsigned*)(p.ws + WS_BAR); xb.x = (unsigned)__builtin_amdgcn_s_getreg((3 << 11) | 20) & 0xFu; xb.nloc = 1u; xb.nx = 1u;
    if (threadIdx.x == 0) (void)xb_add(&xb.bar[XB_CENSUS(xb.x)], 1u);
#ifdef REPORT_MASK
    unsigned long long t_acc = 0;
#endif
    for (int ph = ph_lo; ph < ph_hi; ++ph) {
        int op, L; phase_decode(ph, op, L);
#ifdef REPORT_MASK
        const unsigned long long t_ph0 = __builtin_amdgcn_s_memrealtime();
#endif
        switch (op) {
        case OP_PREP: run_op<1 << OP_PREP>(p, OP_PREP, L, wid_s); break;
        case OP_POOLD: run_op<1 << OP_POOLD>(p, OP_POOLD, L, wid_s); break;
        case OP_POOLG: run_op<1 << OP_DOWN>(p, OP_POOLG, L, wid_s); break;
        case OP_HIN: run_op<1 << OP_HIN>(p, OP_HIN, L, wid_s); break;
        case OP_HDS: run_op<1 << OP_HDS>(p, OP_HDS, L, wid_s); break;
        case OP_HSCAN: run_op<1 << OP_HSCAN>(p, OP_HSCAN, L, wid_s); break;
        case OP_HOUT: run_op<1 << OP_HOUT>(p, OP_HOUT, L, wid_s); break;
        case OP_HPROJ: run_op<1 << OP_DOWN>(p, OP_HPROJ, L, wid_s); break;
#if defined(REPORT_KLOOP) && REPORT_KLOOP == 8
        case OP_UP: run_op<1 << OP_UP>(p, OP_UP, L, wid_s, &t_acc); break;
#else
        case OP_UP: run_op<1 << OP_UP>(p, OP_UP, L, wid_s); break;
#endif
#if defined(REPORT_KLOOP) && REPORT_KLOOP == 9
        case OP_DOWN: run_op<1 << OP_DOWN>(p, OP_DOWN, L, wid_s, &t_acc); break;
#else
        case OP_DOWN: run_op<1 << OP_DOWN>(p, OP_DOWN, L, wid_s, nullptr, true); break;
#endif
        default: run_op<1 << OP_FINAL>(p, OP_FINAL, L, wid_s); break;
        }
        if (ph + 1 < ph_hi) {
            if (ph == ph_lo) {
                cg::this_grid().sync();
                unsigned mine = 0u, cnt = 0u;
#pragma unroll
                for (unsigned j = 0; j < 16; ++j) { const unsigned c = xb_ld(&xb.bar[XB_CENSUS(j)]); cnt += c > 0u ? 1u : 0u; mine = j == xb.x ? c : mine; }
                xb.nloc = (unsigned)__builtin_amdgcn_readfirstlane((int)(mine > 0u ? mine : 1u)); xb.nx = (unsigned)__builtin_amdgcn_readfirstlane((int)(cnt > 0u ? cnt : 1u));
            } else grid_barrier(xb, wid_s);
        }
#ifdef REPORT_MASK
        if ((REPORT_MASK >> op) & 1) t_acc += __builtin_amdgcn_s_memrealtime() - t_ph0;
#endif
    }
#ifdef REPORT_MASK
    { const unsigned long long t_e = __builtin_amdgcn_s_memrealtime(); while (__builtin_amdgcn_s_memrealtime() - t_e < t_acc) __builtin_amdgcn_s_sleep(16); }
#endif
}
template <int OP>
__global__ void __launch_bounds__(512, 2) phase_kernel(Params p, int L) {
    const int wid_s = __builtin_amdgcn_readfirstlane((int)(threadIdx.x >> 6));
    constexpr int MASK = (OP == OP_POOLG || OP == OP_HPROJ) ? (1 << OP_DOWN) : (1 << OP);
    run_op<MASK>(p, OP, L, wid_s);
}
template <int OP> static void launch_phase(const Params& p, int L, int grid, hipStream_t stream) {
    static bool attr = false;
    if (!attr) { (void)hipFuncSetAttribute((const void*)phase_kernel<OP>, hipFuncAttributeMaxDynamicSharedMemorySize, LDS_BYTES); attr = true; }
    hipLaunchKernelGGL(phase_kernel<OP>, dim3(grid), dim3(512), LDS_BYTES, stream, p, L);
}

extern "C" void kernel_launch(void* const* d_in, const int* in_sizes, int n_in, void* d_out, int out_size, void* d_ws, size_t ws_size, hipStream_t stream) {
    static int grid_blocks = 0;
    if (!grid_blocks) {
        hipFuncSetAttribute((const void*)mega, hipFuncAttributeMaxDynamicSharedMemorySize, LDS_BYTES);
        int dev = 0, cus = 0, per_cu = 0; hipGetDevice(&dev);
        hipDeviceGetAttribute(&cus, hipDeviceAttributeMultiprocessorCount, dev);
        hipOccupancyMaxActiveBlocksPerMultiprocessor(&per_cu, mega, 512, LDS_BYTES);
        if (per_cu < 1) per_cu = 1;
        grid_blocks = cus * 1;
        if (ws_size < WS_NEED) fprintf(stderr, "workspace too small: %zu < %zu\n", ws_size, (size_t)WS_NEED);
    }
    if (ws_size < WS_NEED || n_in != 18) return;
    Params p{};
    for (int i = 0; i < 18; ++i) p.in[i] = (const float*)d_in[i];
    p.out = (float*)d_out; p.ws = (unsigned char*)d_ws;
#if defined(BISECT_N)
    for (int ph = 0; ph < BISECT_N; ++ph) hipLaunchKernelGGL(mega, dim3(grid_blocks), dim3(512), LDS_BYTES, stream, p, ph, ph + 1);
#elif MK_SINGLE
    (void)hipMemsetAsync((unsigned char*)d_ws + WS_BAR, 0, XB_BYTES + 256, stream);
    int lo = 0, hi = NPH; void* args[] = {&p, &lo, &hi};
    hipError_t e = hipLaunchCooperativeKernel((const void*)mega, dim3(grid_blocks), dim3(512), args, LDS_BYTES, stream);
    if (e != hipSuccess) fprintf(stderr, "cooperative launch failed: %s (grid %d)\n", hipGetErrorString(e), grid_blocks);
#else
    for (int ph = 0; ph < NPH; ++ph) {
        int op, L;
        if (ph == 0) { op = OP_PREP; L = 0; } else if (ph == 23) { op = OP_FINAL; L = 0; }
        else { int q = ph - 1; const int pr = q / 11; q %= 11;
            if (q < 4) { L = 2 * pr; op = q == 0 ? OP_POOLD : q == 1 ? OP_POOLG : q == 2 ? OP_UP : OP_DOWN; }
            else { q -= 4; L = 2 * pr + 1; op = q == 0 ? OP_HIN : q == 1 ? OP_HDS : q == 2 ? OP_HSCAN : q == 3 ? OP_HOUT : q == 4 ? OP_HPROJ : q == 5 ? OP_UP : OP_DOWN; } }
        switch (op) {
        case OP_PREP: launch_phase<OP_PREP>(p, L, grid_blocks, stream); break;
        case OP_POOLD: launch_phase<OP_POOLD>(p, L, grid_blocks, stream); break;
        case OP_POOLG: launch_phase<OP_POOLG>(p, L, grid_blocks, stream); break;
        case OP_HIN: launch_phase<OP_HIN>(p, L, grid_blocks, stream); break;
        case OP_HDS: launch_phase<OP_HDS>(p, L, grid_blocks, stream); break;
        case OP_HSCAN: launch_phase<OP_HSCAN>(p, L, grid_blocks, stream); break;
        case OP_HOUT: launch_phase<OP_HOUT>(p, L, grid_blocks, stream); break;
        case OP_HPROJ: launch_phase<OP_HPROJ>(p, L, grid_blocks, stream); break;
        case OP_UP: launch_phase<OP_UP>(p, L, grid_blocks, stream); break;
        case OP_DOWN: launch_phase<OP_DOWN>(p, L, grid_blocks, stream); break;
        default: launch_phase<OP_FINAL>(p, L, grid_blocks, stream); break;
        }
    }
#endif
}
```

```cpp
#include <hip/hip_runtime.h>
#include <hip/hip_cooperative_groups.h>
#include <cstdint>
#include <cstdio>
namespace cg = cooperative_groups;


#ifndef MK_SINGLE
#define MK_SINGLE 1
#endif

typedef unsigned short bf16_t;
typedef short bf16x8 __attribute__((ext_vector_type(8)));
typedef float f32x4 __attribute__((ext_vector_type(4)));
typedef float f32x2 __attribute__((ext_vector_type(2)));
typedef unsigned u32x4 __attribute__((ext_vector_type(4)));
typedef unsigned u32x2 __attribute__((ext_vector_type(2)));
typedef _Float16 h16x4 __attribute__((ext_vector_type(4)));

constexpr int M_TOK = 33792, MP = 32768, DM = 1024, FF = 2816, SEQ = 8192, DSEQ = 64;
constexpr float EPS = 1e-6f;
constexpr int BM = 256, BK = 64, HALF = 128, HT = HALF * BK, NXCD = 8, WGM = 8;
constexpr int LDS_RS = 256 * 528;
constexpr int LDS_BYTES = 256 * 528 + 1024;

constexpr size_t MiB = (size_t)1 << 20;
constexpr size_t WS_SSQ = 0;
constexpr size_t WS_LB = 2 * MiB;
constexpr size_t WS_DC = 3 * MiB;
constexpr size_t WS_W = 8 * MiB;
constexpr size_t WS_WUP = WS_W, WS_WDN = WS_W + 44 * MiB, WS_WIN = WS_W + 66 * MiB, WS_WOUT = WS_W + 82 * MiB, WS_WPOOL = WS_W + 86 * MiB;
constexpr size_t WS_XB = 96 * MiB;
constexpr size_t WS_SCR = 162 * MiB;
constexpr size_t WS_HID = WS_SCR, WS_DBUF = WS_SCR, WS_DS = WS_XB  ;
constexpr size_t WS_LF = WS_SCR + 66 * MiB, WS_QB = WS_SCR + 132 * MiB, WS_VB = WS_SCR + 198 * MiB, WS_GB = WS_SCR + 264 * MiB;
constexpr size_t WS_SSQP = WS_SCR + 330 * MiB;
constexpr size_t SSQ_STRIDE = (size_t)M_TOK * 16;
constexpr size_t WS_NEED = WS_SSQP + 9 * SSQ_STRIDE * 4;

constexpr size_t O_Y = 0, O_POOLP = 34603008, O_POOLS = 34725888, O_HGP = 35217408, O_HGS = 36265984, O_CVP = 40460288, O_CVS = 40550400;

struct Params { const float* in[18]; float* out; unsigned char* ws; };
enum { I_XP = 0, I_XS, I_SPOOL, I_SHG, I_SCONV, I_NMIXG, I_POOLW, I_POOLSC, I_HWIN, I_LBLOG, I_HNORMG, I_HWOUT, I_NFFNG, I_WUP, I_CONVW, I_CONVB, I_WDN, I_NOUTG };

extern __shared__ __attribute__((aligned(16))) unsigned char smem[];

typedef __bf16 bf16x2_t __attribute__((ext_vector_type(2)));
__device__ __forceinline__ unsigned cvt_pk_bf16(float lo, float hi) { const f32x2 v = {lo, hi}; const bf16x2_t b = __builtin_convertvector(v, bf16x2_t); return __builtin_bit_cast(unsigned, b); }
__device__ __forceinline__ float bf_lo(unsigned w) { return __uint_as_float(w << 16); }
__device__ __forceinline__ float bf_hi(unsigned w) { return __uint_as_float(w & 0xffff0000u); }
__device__ __forceinline__ float fexp(float x) { return __builtin_amdgcn_exp2f(x * 1.4426950408889634f); }
__device__ __forceinline__ float flog(float x) { return __builtin_amdgcn_logf(x) * 0.6931471805599453f; }
__device__ __forceinline__ float sigmoidf_(float z) { return __builtin_amdgcn_rcpf(1.0f + __builtin_amdgcn_exp2f(z * -1.4426950408889634f)); }
__device__ __forceinline__ float rstd_of(float ssq) { return rsqrtf(ssq * (1.0f / 1024.0f) + EPS); }
__device__ __forceinline__ float rstd_row(const float* sp) { const f32x4 a = *(const f32x4*)sp, b = *(const f32x4*)(sp + 4), c = *(const f32x4*)(sp + 8), d = *(const f32x4*)(sp + 12);
    const f32x4 t = (a + b) + (c + d); return rstd_of((t[0] + t[1]) + (t[2] + t[3])); }

__device__ __forceinline__ const char* uniform_ptr(const void* p) { const unsigned long long v = (unsigned long long)p; const unsigned lo = __builtin_amdgcn_readfirstlane((unsigned)v), hi = __builtin_amdgcn_readfirstlane((unsigned)(v >> 32)); return (const char*)(((unsigned long long)hi << 32) | lo); }
template <int NOP>
__device__ __forceinline__ void glds16(const char* sbase, unsigned voff, unsigned lds_addr) {
    if (NOP) asm volatile("s_mov_b32 m0, %2\n\ts_nop 4\n\tglobal_load_lds_dwordx4 %0, %1" :: "v"(voff), "s"(sbase), "s"(lds_addr) : "memory", "m0");
    else asm volatile("s_mov_b32 m0, %2\n\ts_nop 0\n\tglobal_load_lds_dwordx4 %0, %1" :: "v"(voff), "s"(sbase), "s"(lds_addr) : "memory", "m0");
}
__device__ __forceinline__ int tid_launder(int wid_s) { int l; asm volatile("v_mbcnt_lo_u32_b32 %0, -1, 0\n\tv_mbcnt_hi_u32_b32 %0, -1, %0" : "=v"(l)); return wid_s * 64 + l; }

__device__ __forceinline__ int lds_byte(int r, int c) { int st = (r >> 4) * 2 + (c >> 5), rr = r & 15, cc = c & 31, ob = rr * 64 + cc * 2; return st * 1024 + (ob ^ (((ob >> 9) & 1) << 5)); }
__device__ __forceinline__ void stage_rc(int b, int& R, int& C) { int st = b / 1024, sb = b % 1024, swz = sb ^ (((sb >> 9) & 1) << 5); R = (st >> 1) * 16 + swz / 64; C = (st & 1) * 32 + (swz % 64) / 2; }

struct Unit { int pm, pn, kh; };
__device__ __forceinline__ bool unit_next(int i, int nM, int nN, Unit& u) {
    const int nwg = nM * nN; const long L = (long)i * gridDim.x + blockIdx.x; if (L >= nwg) return false;
    int wgid = (int)L; { const int q = nwg / NXCD, r = nwg % NXCD, xcd = wgid % NXCD, off = wgid / NXCD; wgid = (xcd < r ? xcd * (q + 1) : r * (q + 1) + (xcd - r) * q) + off; }
    const int nig = WGM * nN, gid = wgid / nig, fm = gid * WGM, gsz = (nM - fm) < WGM ? (nM - fm) : WGM;
    u.pm = fm + ((wgid % nig) % gsz); u.pn = (wgid % nig) / gsz; u.kh = -1; return true;
}

struct GemmArgs { const bf16_t* A; const bf16_t* Bt; int lda, ldb, K, nM, nN; };

#define LAS __attribute__((address_space(3)))
template <class Epi>
__device__ __forceinline__ void gemm_phase(const GemmArgs g, const Epi& E, int wid_s, unsigned long long* tk = nullptr) {
    LAS unsigned char* lds = (LAS unsigned char*)smem;
    constexpr int HTB = HT * 2;
#define SA(b, h) (((b) * 2 + (h)) * HTB)
#define SB(b, h) ((4 + (b) * 2 + (h)) * HTB)
#define STAGE(bufoff, gbase, voff) do { _Pragma("unroll") for (int _i = 0; _i < 2; ++_i) glds16<0>((gbase), (voff)[_i], ldsb + (unsigned)((bufoff) + _i * 8192)); } while (0)
#define STAGE0(bufoff, gbase, voff) do { _Pragma("unroll") for (int _i = 0; _i < 2; ++_i) glds16<1>((gbase), (voff)[_i], ldsb + (unsigned)((bufoff) + _i * 8192)); } while (0)
#define LDA(dst, b, h) do { _Pragma("unroll") for (int m = 0; m < 4; ++m) _Pragma("unroll") for (int k = 0; k < 2; ++k) dst[m][k] = *(const LAS bf16x8*)(lds + SA(b, h) + aoff + m * 2048 + k * 1024); } while (0)
#define LDB(dst, b, h) do { _Pragma("unroll") for (int n = 0; n < 2; ++n) _Pragma("unroll") for (int k = 0; k < 2; ++k) dst[n][k] = *(const LAS bf16x8*)(lds + SB(b, h) + boff + n * 2048 + k * 1024); } while (0)
#define MMA(ai, bj, At_, Bt_) do { __builtin_amdgcn_s_setprio(1); _Pragma("unroll") for (int m = 0; m < 4; ++m) _Pragma("unroll") for (int n = 0; n < 2; ++n) _Pragma("unroll") for (int k = 0; k < 2; ++k) \
      acc[ai][bj][m][n] = __builtin_amdgcn_mfma_f32_16x16x32_bf16(Bt_[n][k], At_[m][k], acc[ai][bj][m][n], 0, 0, 0); \
    __builtin_amdgcn_s_setprio(0); } while (0)
#define WAIT_V(n) asm volatile("s_waitcnt vmcnt(" #n ")" ::: "memory")
#define WAIT_L(n) asm volatile("s_waitcnt lgkmcnt(" #n ")" ::: "memory")
#define BAR __builtin_amdgcn_s_barrier()
#define SCHED __builtin_amdgcn_sched_barrier(0)
    const int tid = tid_launder(wid_s), wid = __builtin_amdgcn_readfirstlane(tid >> 6), lane = tid & 63, wr = wid >> 2, wc = wid & 3, fr = lane & 15, fq = lane >> 4;
    const int nt_full = g.K / BK;
    unsigned voffA[2], voffB[2];
#pragma unroll
    for (int i = 0; i < 2; ++i) { int R, C; stage_rc(tid * 16 + i * 8192, R, C); const int rho = R & 31, Rb = (R & ~31) + 8 * ((rho & 15) >> 2) + 4 * (rho >> 4) + (rho & 3);
        voffA[i] = (unsigned)(R * g.lda + C) * 2u; voffB[i] = (unsigned)(Rb * g.ldb + C) * 2u; }
    const size_t kstep = (size_t)(BK * 2), hstepA = (size_t)HALF * g.lda * 2, hstepB = (size_t)HALF * g.ldb * 2;
    const unsigned ldsb = (unsigned)__builtin_amdgcn_readfirstlane((int)(unsigned)(unsigned long long)(LAS unsigned char*)smem) + (unsigned)wid * 1024u;
    const int aoff = lds_byte(wr * 64 + fr, fq * 8), boff = lds_byte(wc * 32 + fr, fq * 8);
    Unit u;
    for (int it = 0; E.next(it, g.nM, g.nN, u); ++it) {
        const int nt = u.kh < 0 ? nt_full : nt_full / 2, kh0 = u.kh > 0 ? (nt_full / 2) * BK : 0;
        const char* cA = uniform_ptr(g.A + E.a_row0(u) * (long)g.lda + E.a_koff(u) + kh0);
        const char* cB = uniform_ptr(g.Bt + (long)u.pn * BM * g.ldb + kh0);
        f32x4 acc[2][2][4][2];
#pragma unroll
        for (int a = 0; a < 2; ++a)
#pragma unroll
            for (int b = 0; b < 2; ++b)
#pragma unroll
                for (int m = 0; m < 4; ++m)
#pragma unroll
                    for (int n = 0; n < 2; ++n) acc[a][b][m][n] = (f32x4){0.f, 0.f, 0.f, 0.f};
        bf16x8 At[4][2], B0[2][2], B1[2][2];
#ifdef REPORT_KLOOP
        const unsigned long long tk0 = __builtin_amdgcn_s_memrealtime();
#endif
        STAGE0(SB(0, 0), cB, voffB); STAGE0(SA(0, 0), cA, voffA); STAGE0(SB(0, 1), cB + hstepB, voffB); STAGE0(SA(0, 1), cA + hstepA, voffA);
        if (wr == 1) BAR;
        WAIT_V(4); BAR;
        STAGE0(SB(1, 0), cB + kstep, voffB); STAGE0(SA(1, 0), cA + kstep, voffA); STAGE0(SB(1, 1), cB + hstepB + kstep, voffB);
        WAIT_V(6); BAR;
        for (int t = 0; t < nt - 2; t += 2) {
            const char* a1 = cA + (size_t)(t + 1) * kstep; const char* a2 = cA + (size_t)(t + 2) * kstep; const char* b2 = cB + (size_t)(t + 2) * kstep;
            const char* a3 = a2 + kstep; const char* b3 = b2 + kstep;
            LDB(B0, 0, 0); SCHED; LDA(At, 0, 0); STAGE(SA(1, 1), a1 + hstepA, voffA);
            WAIT_L(8); BAR; WAIT_L(0); MMA(0, 0, At, B0); BAR; SCHED;
            LDB(B1, 0, 1); STAGE(SB(0, 0), b2, voffB);
            BAR; WAIT_L(0); MMA(0, 1, At, B1); BAR;
            LDA(At, 0, 1); STAGE(SA(0, 0), a2, voffA);
            BAR; WAIT_L(0); MMA(1, 0, At, B0); BAR; SCHED;
            STAGE(SB(0, 1), b2 + hstepB, voffB);
            WAIT_V(6); BAR; MMA(1, 1, At, B1); BAR;
            LDB(B0, 1, 0); SCHED; LDA(At, 1, 0); STAGE(SA(0, 1), a2 + hstepA, voffA);
            WAIT_L(8); BAR; WAIT_L(0); MMA(0, 0, At, B0); BAR; SCHED;
            LDB(B1, 1, 1); STAGE(SB(1, 0), b3, voffB);
            BAR; WAIT_L(0); MMA(0, 1, At, B1); BAR;
            LDA(At, 1, 1); STAGE(SA(1, 0), a3, voffA);
            BAR; WAIT_L(0); MMA(1, 0, At, B0); BAR; SCHED;
            STAGE(SB(1, 1), b3 + hstepB, voffB);
            WAIT_V(6); BAR; MMA(1, 1, At, B1); BAR;
        }
        { LDB(B0, 0, 0); LDA(At, 0, 0); STAGE0(SA(1, 1), cA + (size_t)(nt - 1) * kstep + hstepA, voffA);
          BAR; WAIT_L(0); MMA(0, 0, At, B0); BAR;
          LDB(B1, 0, 1); BAR; WAIT_L(0); MMA(0, 1, At, B1); BAR;
          LDA(At, 0, 1); WAIT_V(4); BAR; WAIT_L(0); MMA(1, 0, At, B0); MMA(1, 1, At, B1); BAR; }
        { LDB(B0, 1, 0); LDA(At, 1, 0); WAIT_V(2); BAR; WAIT_L(0); MMA(0, 0, At, B0); BAR;
          LDB(B1, 1, 1); WAIT_V(0); BAR; WAIT_L(0); MMA(0, 1, At, B1); BAR;
          LDA(At, 1, 1); BAR; WAIT_L(0); MMA(1, 0, At, B0); MMA(1, 1, At, B1); BAR; }
        if (wr == 0) BAR;
#ifdef REPORT_KLOOP
        if (tk) *tk += __builtin_amdgcn_s_memrealtime() - tk0;
#endif
        { int l2_; asm volatile("v_mbcnt_lo_u32_b32 %0, -1, 0\n\tv_mbcnt_hi_u32_b32 %0, -1, %0" : "=v"(l2_)); const int fr_ = l2_ & 15, fq_ = l2_ >> 4;
          E(acc, u, wr, wc, fr_, fq_); }
        asm volatile("s_waitcnt vmcnt(0) lgkmcnt(0)" ::: "memory");
        __syncthreads();
    }
}

__device__ __forceinline__ f32x4 ldg4(const bf16_t* p) { const u32x2 w = *(const u32x2*)p; return (f32x4){bf_lo(w.x), bf_hi(w.x), bf_lo(w.y), bf_hi(w.y)}; }
struct EpiResid {
    const float* xin_p; const float* xin_s; float* xf; bf16_t* xb; float* ssq; const float* colscale; int koff_per_pn;
    unsigned* flags;
    __device__ __forceinline__ bool next(int it, int nM, int nN, Unit& u) const {
        if (!flags) return unit_next(it, nM, nN, u);
        const int L = it * (int)gridDim.x + (int)blockIdx.x;
        if (L < 512) return unit_next(it, 128, 4, u);
        const int s = L - 512; if (s >= 32) return false;
        u.pm = 128 + (s >> 3); u.pn = (s >> 1) & 3; u.kh = s & 1; return true;
    }
    __device__ __forceinline__ long a_row0(const Unit& u) const { return (long)u.pm * BM; }
    __device__ __forceinline__ int a_koff(const Unit& u) const { return u.pn * koff_per_pn; }
    __device__ __forceinline__ void operator()(f32x4 (&acc)[2][2][4][2], const Unit& u, int wr, int wc, int fr, int fq) const {
        unsigned* flag = flags ? flags + ((u.pm - 128) * 4 + u.pn) : nullptr;
        if (u.kh == 1) {
            if (wr == 0 && wc == 0) {
                while (__hip_atomic_load(flag, __ATOMIC_RELAXED, __HIP_MEMORY_SCOPE_AGENT) == 0u) __builtin_amdgcn_s_sleep(2);
                __builtin_amdgcn_fence(__ATOMIC_ACQUIRE, "agent");
                asm volatile("s_waitcnt vmcnt(0)" ::: "memory");
            }
            __syncthreads();
        }
        const bool part = u.kh == 0;
        f32x4 csv[2][2];
#pragma unroll
        for (int bj = 0; bj < 2; ++bj)
#pragma unroll
            for (int n = 0; n < 2; ++n) csv[bj][n] = colscale ? *(const f32x4*)(colscale + u.pn * BM + bj * HALF + wc * 32 + fq * 8 + 4 * n) : (f32x4){1.f, 1.f, 1.f, 1.f};
#pragma unroll
        for (int ai = 0; ai < 2; ++ai)
#pragma unroll
            for (int m = 0; m < 4; ++m) {
                const int row = u.pm * BM + ai * HALF + wr * 64 + m * 16 + fr;
                const float* xr = xin_p ? (row < MP ? xin_p + (size_t)row * DM : xin_s + (size_t)(row - MP) * DM) : xf + (size_t)row * DM;
                const bool from_bf = !xin_p && u.kh != 1;
                float ss = 0.f;
#pragma unroll
                for (int bj = 0; bj < 2; ++bj) {
                    const int col = u.pn * BM + bj * HALF + wc * 32 + fq * 8;
                    f32x4 v0 = acc[ai][bj][m][0], v1 = acc[ai][bj][m][1];
                    if (colscale) { v0 = v0 * csv[bj][0]; v1 = v1 * csv[bj][1]; }
                    if (from_bf) { const u32x4 xw = *(const u32x4*)(xb + (size_t)row * DM + col);
                        v0 = v0 + (f32x4){bf_lo(xw.x), bf_hi(xw.x), bf_lo(xw.y), bf_hi(xw.y)}; v1 = v1 + (f32x4){bf_lo(xw.z), bf_hi(xw.z), bf_lo(xw.w), bf_hi(xw.w)}; }
                    else { v0 = v0 + *(const f32x4*)(xr + col); v1 = v1 + *(const f32x4*)(xr + col + 4); }
                    if (part) { *(f32x4*)(xf + (size_t)row * DM + col) = v0; *(f32x4*)(xf + (size_t)row * DM + col + 4) = v1; }
                    else {
                        u32x4 w; w.x = cvt_pk_bf16(v0[0], v0[1]); w.y = cvt_pk_bf16(v0[2], v0[3]); w.z = cvt_pk_bf16(v1[0], v1[1]); w.w = cvt_pk_bf16(v1[2], v1[3]);
                        *(u32x4*)(xb + (size_t)row * DM + col) = w;
                        ss += ((v0[0] * v0[0] + v0[1] * v0[1]) + (v0[2] * v0[2] + v0[3] * v0[3])) + ((v1[0] * v1[0] + v1[1] * v1[1]) + (v1[2] * v1[2] + v1[3] * v1[3]));
                    }
                }
                ss += __shfl_xor(ss, 16); ss += __shfl_xor(ss, 32);
                if (fq == 0 && !part) ssq[(size_t)row * 16 + u.pn * 4 + wc] = ss;
                asm volatile("" ::: "memory");
            }
        if (part) {
            asm volatile("s_waitcnt vmcnt(0)" ::: "memory");
            __syncthreads();
            if (wr == 0 && wc == 0 && fr == 0 && fq == 0) {
                __builtin_amdgcn_fence(__ATOMIC_RELEASE, "agent");
                asm volatile("s_waitcnt vmcnt(0)" ::: "memory");
                __hip_atomic_store(flag, 1u, __ATOMIC_RELAXED, __HIP_MEMORY_SCOPE_AGENT);
            }
        }
    }
};

struct EpiHin {
    __device__ __forceinline__ bool next(int it, int nM, int nN, Unit& u) const { return unit_next(it, nM, nN, u); }
    const float* ssq; const float* lb; unsigned char* ws; mutable int last_pm;
    __device__ __forceinline__ long a_row0(const Unit& u) const { return (long)u.pm * BM; }
    __device__ __forceinline__ int a_koff(const Unit&) const { return 0; }
    __device__ __forceinline__ void operator()(f32x4 (&acc)[2][2][4][2], const Unit& u, int wr, int wc, int fr, int fq) const {
        const int sec = u.pn >> 2;
        float* rsT = (float*)(smem + LDS_RS);
        const bool fresh = u.pm != last_pm;
        if (fresh) { const int t = (wr * 4 + wc) * 64 + fq * 16 + fr; if (t < 256) rsT[t] = rstd_row(ssq + (size_t)(u.pm * BM + t) * 16); }
        f32x4 lbv[2][2];
#pragma unroll
        for (int bj = 0; bj < 2; ++bj)
#pragma unroll
            for (int n = 0; n < 2; ++n) lbv[bj][n] = sec == 1 ? *(const f32x4*)(lb + (u.pn & 3) * BM + bj * HALF + wc * 32 + fq * 8 + 4 * n) : (f32x4){0.f, 0.f, 0.f, 0.f};
        if (fresh) { __syncthreads(); last_pm = u.pm; }
#pragma unroll
        for (int ai = 0; ai < 2; ++ai)
#pragma unroll
            for (int m = 0; m < 4; ++m) {
                const int row = u.pm * BM + ai * HALF + wr * 64 + m * 16 + fr;
                const float rs = rsT[ai * HALF + wr * 64 + m * 16 + fr];
#pragma unroll
                for (int bj = 0; bj < 2; ++bj) {
                    const int cs = (u.pn & 3) * BM + bj * HALF + wc * 32 + fq * 8;
                    const size_t o = (size_t)row * DM + cs;
                    u32x4 w;
#pragma unroll
                    for (int n = 0; n < 2; ++n) {
                        const f32x4 z = acc[ai][bj][m][n] * rs; unsigned p0, p1;
                        if (sec == 1) {
                            const f32x4 l4 = lbv[bj][n]; h16x4 h;
#pragma unroll
                            for (int j = 0; j < 4; ++j) { const float f = l4[j] + (1.0f - l4[j]) * sigmoidf_(z[j]); h[j] = (_Float16)flog(f); }
                            const u32x2 hw = __builtin_bit_cast(u32x2, h); p0 = hw.x; p1 = hw.y;
                        } else {
                            f32x4 r = z;
                            if (sec != 2) {
#pragma unroll
                                for (int j = 0; j < 4; ++j) r[j] = z[j] * sigmoidf_(z[j]);
                            }
                            p0 = cvt_pk_bf16(r[0], r[1]); p1 = cvt_pk_bf16(r[2], r[3]);
                        }
                        if (n == 0) { w.x = p0; w.y = p1; } else { w.z = p0; w.w = p1; }
                    }
                    unsigned char* dst = sec == 1 ? ws + WS_LF : ws + WS_QB + (size_t)(sec == 0 ? 0 : sec - 1) * (66 * MiB);
                    *(u32x4*)(dst + o * 2) = w;
                }
            }
    }
};

struct EpiUp {
    __device__ __forceinline__ bool next(int it, int nM, int nN, Unit& u) const { return unit_next(it, nM, nN, u); }
    mutable int last_pm;
    const float* ssq; const float* cw; const float* cb; const float* hist; bf16_t* hid; float* cvp; float* cvs;
    __device__ __forceinline__ long a_row0(const Unit& u) const { return u.pm < 132 ? (long)(u.pm / 33) * SEQ + 254 * (u.pm % 33) - 2 : (long)MP + 256 * (u.pm - 132); }
    __device__ __forceinline__ int a_koff(const Unit&) const { return 0; }
    __device__ __forceinline__ void operator()(f32x4 (&acc)[2][2][4][2], const Unit& u, int wr, int wc, int fr, int fq) const {
        float* G = (float*)smem;
        const bool prompt = u.pm < 132; const int tt = u.pm % 33;
        const long rbase = a_row0(u);
        const long row_end = prompt ? (long)(u.pm / 33 + 1) * SEQ : (long)M_TOK;
        const int cl0 = wc * 32 + fq * 8, c0 = u.pn * HALF + cl0;
        f32x4 w0[2], w1[2], w2[2], bb[2];
#pragma unroll
        for (int n = 0; n < 2; ++n) { w0[n] = *(const f32x4*)(cw + c0 + 4 * n); w1[n] = *(const f32x4*)(cw + FF + c0 + 4 * n); w2[n] = *(const f32x4*)(cw + 2 * FF + c0 + 4 * n); bb[n] = *(const f32x4*)(cb + c0 + 4 * n); }
        float* rsT = (float*)(smem + LDS_RS);
        if (u.pm != last_pm) {
            const int t = (wr * 4 + wc) * 64 + fq * 16 + fr; if (t < 256) { long gr = rbase + t; if (gr < 0) gr = 0; rsT[t] = rstd_row(ssq + (size_t)gr * 16); }
            __syncthreads(); last_pm = u.pm; }
#pragma unroll
        for (int ai = 0; ai < 2; ++ai)
#pragma unroll
            for (int m = 0; m < 4; ++m) {
                const int lrow = ai * HALF + wr * 64 + m * 16 + fr;
                const float rsv = rsT[lrow];
                const bool zero = prompt && tt == 0 && lrow < 2;
#pragma unroll
                for (int n = 0; n < 2; ++n) {
                    f32x4 gv = acc[ai][0][m][n] * rsv; acc[ai][1][m][n] = acc[ai][1][m][n] * rsv; if (zero) gv = (f32x4){0.f, 0.f, 0.f, 0.f};
                    acc[ai][0][m][n] = gv;
                    *(f32x4*)(G + lrow * 132 + wc * 32 + fq * 8 + n * 4) = gv;
                }
            }
        __syncthreads();
        if (prompt) {
#pragma unroll
            for (int ai = 0; ai < 2; ++ai)
#pragma unroll
                for (int m = 0; m < 4; ++m) {
                    const int lrow = ai * HALF + wr * 64 + m * 16 + fr; const long gr = rbase + lrow;
                    if (lrow >= 2 && gr < row_end) {
                        const float* Gp = G + (lrow - 2) * 132 + cl0; bf16_t* hp = hid + (size_t)gr * FF + c0; u32x4 hw;
#pragma unroll
                        for (int n = 0; n < 2; ++n) {
                            const f32x4 g2 = *(const f32x4*)(Gp + 4 * n), g1 = *(const f32x4*)(Gp + 132 + 4 * n), g0 = acc[ai][0][m][n];
                            const f32x4 cv = bb[n] + w0[n] * g2 + w1[n] * g1 + w2[n] * g0, vv = acc[ai][1][m][n];
                            f32x4 h;
#pragma unroll
                            for (int j = 0; j < 4; ++j) h[j] = cv[j] * sigmoidf_(cv[j]) * vv[j];
                            if (n == 0) { hw.x = cvt_pk_bf16(h[0], h[1]); hw.y = cvt_pk_bf16(h[2], h[3]); } else { hw.z = cvt_pk_bf16(h[0], h[1]); hw.w = cvt_pk_bf16(h[2], h[3]); }
                        }
                        *(u32x4*)hp = hw;
                        const int l = (int)(gr & (SEQ - 1));
                        if (l >= SEQ - 2) {
                            float* cp = cvp + ((size_t)(gr >> 13) * 2 + (l - (SEQ - 2))) * FF + c0;
                            *(f32x4*)cp = acc[ai][0][m][0]; *(f32x4*)(cp + 4) = acc[ai][0][m][1];
                        }
                    }
                }
        } else {
#pragma unroll
            for (int ai = 0; ai < 2; ++ai)
#pragma unroll
                for (int m = 0; m < 4; ++m) {
                    const int lrow = ai * HALF + wr * 64 + m * 16 + fr, l = lrow & 63; const long gr = rbase + lrow;
                    const int b = (int)(gr - MP) >> 6; const float* hb = hist + (size_t)b * 2 * FF + c0; bf16_t* hp = hid + (size_t)gr * FF + c0;
#pragma unroll
                    for (int n = 0; n < 2; ++n) {
                        f32x4 g1, g2; const f32x4 g0 = acc[ai][0][m][n];
                        if (l >= 2) { g1 = *(const f32x4*)(G + (lrow - 1) * 132 + cl0 + 4 * n); g2 = *(const f32x4*)(G + (lrow - 2) * 132 + cl0 + 4 * n); }
                        else if (l == 0) { g2 = *(const f32x4*)(hb + 4 * n); g1 = *(const f32x4*)(hb + FF + 4 * n); }
                        else { g2 = *(const f32x4*)(hb + FF + 4 * n); g1 = *(const f32x4*)(G + (lrow - 1) * 132 + cl0 + 4 * n); }
                        const f32x4 cv = bb[n] + w0[n] * g2 + w1[n] * g1 + w2[n] * g0, vv = acc[ai][1][m][n];
                        f32x4 h;
#pragma unroll
                        for (int j = 0; j < 4; ++j) h[j] = cv[j] * sigmoidf_(cv[j]) * vv[j];
                        u32x2 w; w.x = cvt_pk_bf16(h[0], h[1]); w.y = cvt_pk_bf16(h[2], h[3]);
                        *(u32x2*)(hp + 4 * n) = w;
                        if (l >= 62) *(f32x4*)(cvs + ((size_t)b * 2 + (l - 62)) * FF + c0 + 4 * n) = g0;
                    }
                    asm volatile("" ::: "memory");
                }
        }
    }
};


__device__ __forceinline__ void prep_tile(const float* W, int K, int N, const float* gk, bf16_t* Wt, int k0, int n0, int nd0, int wid_s) {
    bf16_t* T = (bf16_t*)smem;
    const int tid = tid_launder(wid_s), ln = tid & 31;
#pragma unroll
    for (int i = 0; i < 8; ++i) {
        const int k = i * 16 + (tid >> 5);
        f32x4 v = *(const f32x4*)(W + (size_t)(k0 + k) * N + n0 + ln * 4);
        if (gk) v = v * gk[k0 + k];
        const unsigned p0 = cvt_pk_bf16(v[0], v[1]), p1 = cvt_pk_bf16(v[2], v[3]);
        T[(0 * 32 + ln) * 130 + k] = (bf16_t)(p0 & 0xffff); T[(1 * 32 + ln) * 130 + k] = (bf16_t)(p0 >> 16);
        T[(2 * 32 + ln) * 130 + k] = (bf16_t)(p1 & 0xffff); T[(3 * 32 + ln) * 130 + k] = (bf16_t)(p1 >> 16);
    }
    __syncthreads();
#pragma unroll
    for (int i = 0; i < 4; ++i) {
        const int n = i * 32 + (tid >> 4), kq = (tid & 15) * 8;
        const unsigned* src = (const unsigned*)(T + ((n & 3) * 32 + (n >> 2)) * 130 + kq);
        u32x4 v; v.x = src[0]; v.y = src[1]; v.z = src[2]; v.w = src[3];
        *(u32x4*)(Wt + (size_t)(nd0 + n) * K + k0 + kq) = v;
    }
    __syncthreads();
}

__device__ __forceinline__ void prep_weights_layer(const Params& p, int L, int first, int stride, int wid_s) {
    unsigned char* ws = p.ws; const int j = L >> 1; const int nt = 528 + ((L & 1) ? 320 : 16);
    for (int t = first; t < nt; t += stride) {
        const float* W; const float* gk = nullptr; bf16_t* Wt; int K, N, lt, mode = 0;
        if (t < 352) { lt = t; K = DM; N = 2 * FF; W = p.in[I_WUP] + (size_t)L * DM * 2 * FF; gk = p.in[I_NFFNG] + L * DM; Wt = (bf16_t*)(ws + WS_WUP) + (size_t)L * 2 * FF * DM; mode = 1; }
        else if (t < 528) { lt = t - 352; K = FF; N = DM; W = p.in[I_WDN] + (size_t)L * FF * DM; Wt = (bf16_t*)(ws + WS_WDN) + (size_t)L * DM * FF; }
        else if (!(L & 1)) { const int mg = j * 4 + (t - 528) / 4; lt = (t - 528) % 4; K = 256; N = 256; W = p.in[I_POOLW] + (size_t)mg * 65536; Wt = (bf16_t*)(ws + WS_WPOOL) + (size_t)mg * 65536; }
        else if (t < 528 + 256) { lt = t - 528; K = DM; N = 4 * DM; W = p.in[I_HWIN] + (size_t)j * DM * 4 * DM; gk = p.in[I_NMIXG] + L * DM; Wt = (bf16_t*)(ws + WS_WIN) + (size_t)j * 4 * DM * DM; }
        else { lt = t - 784; K = DM; N = DM; W = p.in[I_HWOUT] + (size_t)j * DM * DM; Wt = (bf16_t*)(ws + WS_WOUT) + (size_t)j * DM * DM; }
        const int nkb = K / 128, kb = lt % nkb, nb = lt / nkb;
        int nd0 = nb * 128; if (mode == 1) nd0 = nb < 22 ? nb * 256 : (nb - 22) * 256 + 128;
        prep_tile(W, K, N, gk, Wt, kb * 128, nb * 128, nd0, wid_s);
    }
}

__device__ __forceinline__ void phase_prep(const Params& p, int wid_s) {
    unsigned char* ws = p.ws;
    prep_weights_layer(p, 0, blockIdx.x, gridDim.x, wid_s);
    const int tidp = tid_launder(wid_s); const int gtid = blockIdx.x * blockDim.x + tidp, gsz = gridDim.x * blockDim.x;
    for (int c = gtid; c < DM; c += gsz) {
        const float* lg = p.in[I_LBLOG]; float a0 = lg[c], a1 = lg[DM + c], a2 = lg[2 * DM + c], a3 = lg[3 * DM + c];
        const float mx = fmaxf(fmaxf(a0, a1), fmaxf(a2, a3)); a0 = expf(a0 - mx); a1 = expf(a1 - mx); a2 = expf(a2 - mx); a3 = expf(a3 - mx);
        const float inv = 1.0f / (a0 + a1 + a2 + a3); float* lb = (float*)(ws + WS_LB);
        lb[c] = 0.f; lb[DM + c] = a1 * inv; lb[2 * DM + c] = (a1 + a2) * inv; lb[3 * DM + c] = (a1 + a2 + a3) * inv;
    }
    const int wv = gtid >> 6, nwv = gsz >> 6, lane = tidp & 63;
    bf16_t* xb = (bf16_t*)(ws + WS_XB); float* ssq0 = (float*)(ws + WS_SSQP);
    for (int row = wv; row < M_TOK; row += nwv) {
        const float* xr = row < MP ? p.in[I_XP] + (size_t)row * DM : p.in[I_XS] + (size_t)(row - MP) * DM;
        float ss = 0.f;
#pragma unroll
        for (int i = 0; i < 4; ++i) {
            const f32x4 v = *(const f32x4*)(xr + i * 256 + lane * 4);
            ss += (v[0] * v[0] + v[1] * v[1]) + (v[2] * v[2] + v[3] * v[3]);
            u32x2 w; w.x = cvt_pk_bf16(v[0], v[1]); w.y = cvt_pk_bf16(v[2], v[3]);
            *(u32x2*)(xb + (size_t)row * DM + i * 256 + lane * 4) = w;
        }
#pragma unroll
        for (int o = 32; o >= 1; o >>= 1) ss += __shfl_xor(ss, o);
        if (lane < 16) ssq0[(size_t)row * 16 + lane] = lane == 0 ? ss : 0.f;
    }
}

template <int WIN>
__device__ __forceinline__ void pool_walk(const Params& p, int L, int sgi, const float* rsT, int tid) {
    const int  c0 = tid * 2, j = L >> 1;
    const int R0 = sgi * 64; const bool prompt = R0 < MP;
    const int b = prompt ? R0 >> 13 : (R0 - MP) >> 6, l0 = prompt ? (R0 & (SEQ - 1)) : 0, Lseq = prompt ? SEQ : DSEQ;
    const bf16_t* xb = (const bf16_t*)(p.ws + WS_XB); bf16_t* dbuf = (bf16_t*)(p.ws + WS_DBUF);
    const f32x2 g2 = *(const f32x2*)(p.in[I_NMIXG] + L * DM + c0);
    const float* hist = p.in[I_SPOOL] + ((size_t)j * 16 + b) * 15 * DM + c0;
    float* outp = prompt ? p.out + O_POOLP + ((size_t)j * 4 + b) * 15 * DM + c0 : p.out + O_POOLS + ((size_t)j * 16 + b) * 15 * DM + c0;
    unsigned raw[79]; f32x2 hv[15];
    const bool warm = l0 >= 15;
    const bf16_t* xp = xb + (size_t)(R0 - 15) * DM + c0;
#pragma unroll
    for (int i = 15; i < 79; ++i) raw[i] = *(const unsigned*)(xp + (size_t)i * DM);
    if (warm) {
#pragma unroll
        for (int i = 0; i < 15; ++i) raw[i] = *(const unsigned*)(xp + (size_t)i * DM);
    } else {
#pragma unroll
        for (int i = 0; i < 15; ++i) raw[i] = 0u;
    }
    if (!prompt) {
#pragma unroll
        for (int i = 0; i < 15; ++i) hv[i] = *(const f32x2*)(hist + (size_t)i * DM);
    } else {
#pragma unroll
        for (int i = 0; i < 15; ++i) hv[i] = (f32x2){0.f, 0.f};
    }
    float r0[16], r1[16]; float s0 = 0.f, s1 = 0.f;
#pragma unroll
    for (int k = 0; k < 16; ++k) { r0[k] = 0.f; r1[k] = 0.f; }
#pragma unroll
    for (int i = 0; i < 79; ++i) {
        const int k = i & 15, li = l0 - 15 + i;
        float h0, h1;
        if (i >= 15 || warm) { const float rs = rsT[i]; h0 = bf_lo(raw[i]) * rs * g2.x; h1 = bf_hi(raw[i]) * rs * g2.y; }
        else { h0 = hv[i < 15 ? i : 0].x; h1 = hv[i < 15 ? i : 0].y; }
        s0 += h0 - r0[(k - WIN) & 15]; s1 += h1 - r1[(k - WIN) & 15];
        r0[k] = h0; r1[k] = h1;
        if (i >= 15) {
            const int cnt = prompt ? (li + 1 < WIN ? li + 1 : WIN) : WIN; const float inv = 1.0f / (float)cnt;
            *(unsigned*)(dbuf + (size_t)(R0 + i - 15) * DM + c0) = cvt_pk_bf16(s0 * inv - h0, s1 * inv - h1);
            if (li >= Lseq - 15) *(f32x2*)(outp + (size_t)(li - (Lseq - 15)) * DM) = (f32x2){h0, h1};
        }
    }
}
__device__ __forceinline__ void phase_pool_d(const Params& p, int L, int wid_s) {
    float* rsT = (float*)smem; const float* ssq = (const float*)(p.ws + WS_SSQP) + (size_t)(2 * L) * SSQ_STRIDE;
    const int tid = tid_launder(wid_s);
    for (int sgi = blockIdx.x; sgi < M_TOK / 64; sgi += gridDim.x) {
        const int R0 = sgi * 64;
        __syncthreads();
        if (tid < 79) { const int r = R0 - 15 + tid; rsT[tid] = rstd_row(ssq + (size_t)(r < 0 ? 0 : r) * 16); }
        __syncthreads();
        switch (tid >> 7) { case 0: pool_walk<2>(p, L, sgi, rsT, tid); break; case 1: pool_walk<4>(p, L, sgi, rsT, tid); break; case 2: pool_walk<8>(p, L, sgi, rsT, tid); break; default: pool_walk<16>(p, L, sgi, rsT, tid); break; }
    }
}

struct ChunkB { float lf[4][4]; float b[4][4]; float bref[4]; float bC[4]; };
__device__ __forceinline__ void lds_barrier() { asm volatile("s_waitcnt lgkmcnt(0)" ::: "memory"); __builtin_amdgcn_s_barrier(); asm volatile("" ::: "memory"); }
struct ChunkRaw { u32x2 lf[4]; };
__device__ __forceinline__ void chunk_load_lf(const _Float16* lfp, ChunkRaw& r, int tid) {
    const int cg = tid & 31, rg = tid >> 5;
#pragma unroll
    for (int i = 0; i < 4; ++i) r.lf[i] = *(const u32x2*)(lfp + (size_t)(4 * rg + i) * DM + 4 * cg);
}
__device__ __forceinline__ void chunk_cumsum(const ChunkRaw& r, ChunkB& cb, float* T  , int tid) {
    const int cg = tid & 31, rg = tid >> 5;
#pragma unroll
    for (int i = 0; i < 4; ++i) { const h16x4 h = __builtin_bit_cast(h16x4, r.lf[i]);
#pragma unroll
        for (int j = 0; j < 4; ++j) cb.lf[i][j] = (float)h[j]; }
#pragma unroll
    for (int j = 0; j < 4; ++j) { cb.b[0][j] = cb.lf[0][j]; cb.b[1][j] = cb.b[0][j] + cb.lf[1][j]; cb.b[2][j] = cb.b[1][j] + cb.lf[2][j]; cb.b[3][j] = cb.b[2][j] + cb.lf[3][j]; }
    *(f32x4*)(T + rg * 128 + 4 * cg) = (f32x4){cb.b[3][0], cb.b[3][1], cb.b[3][2], cb.b[3][3]};
    lds_barrier();
    f32x4 off = {0.f, 0.f, 0.f, 0.f}, br = {0.f, 0.f, 0.f, 0.f}, bc = {0.f, 0.f, 0.f, 0.f};
#pragma unroll
    for (int r2 = 0; r2 < 16; ++r2) { const f32x4 t = *(const f32x4*)(T + r2 * 128 + 4 * cg); if (r2 < rg) off = off + t; if (r2 < 8) br = br + t; bc = bc + t; }
#pragma unroll
    for (int j = 0; j < 4; ++j) { cb.bref[j] = br[j]; cb.bC[j] = bc[j];
#pragma unroll
        for (int i = 0; i < 4; ++i) cb.b[i][j] += off[j]; }
}

__device__ __forceinline__ void phase_hds(const Params& p, int wid_s) {
    unsigned char* ws = p.ws;
    float* T = (float*)smem;
    unsigned char* KdT = smem + 8192;
    unsigned char* Vt = KdT + 128 * 144;
    const _Float16* lf = (const _Float16*)(ws + WS_LF); const bf16_t* vb = (const bf16_t*)(ws + WS_VB);
    bf16_t* dS = (bf16_t*)(p.out + O_Y); float* dc = (float*)(ws + WS_DC);
    const int tid = tid_launder(wid_s), cg = tid & 31, rg = tid >> 5, wid = tid >> 6, lane = tid & 63, fr = lane & 15, fq = lane >> 4;
    ChunkRaw nraw; u32x2 nv[4];
    { const int u0 = blockIdx.x; if (u0 < 4224) { const size_t org0 = (size_t)(u0 >> 3) * 64 * DM + (u0 & 7) * 128; chunk_load_lf(lf + org0, nraw, tid);
#pragma unroll
        for (int i = 0; i < 4; ++i) nv[i] = *(const u32x2*)(vb + org0 + (size_t)(4 * rg + i) * DM + 4 * cg); } }
    for (int u = blockIdx.x; u < 4224; u += gridDim.x) {
        const ChunkRaw raw = nraw; u32x2 cv[4];
#pragma unroll
        for (int i = 0; i < 4; ++i) cv[i] = nv[i];
        { const int un = u + (int)gridDim.x; if (un < 4224) { const size_t orgn = (size_t)(un >> 3) * 64 * DM + (un & 7) * 128; chunk_load_lf(lf + orgn, nraw, tid);
#pragma unroll
            for (int i = 0; i < 4; ++i) nv[i] = *(const u32x2*)(vb + orgn + (size_t)(4 * rg + i) * DM + 4 * cg); } }
        lds_barrier();
        ChunkB cb; chunk_cumsum(raw, cb, T, tid);
        float kd[4][4]; unsigned vw[4][2];
#pragma unroll
        for (int i = 0; i < 4; ++i) { const u32x2 w = cv[i]; vw[i][0] = w.x; vw[i][1] = w.y;
#pragma unroll
            for (int j = 0; j < 4; ++j) kd[i][j] = (1.0f - fexp(cb.lf[i][j])) * fexp(cb.bC[j] - cb.b[i][j]); }
#pragma unroll
        for (int j = 0; j < 4; ++j) {
            u32x2 w; w.x = cvt_pk_bf16(kd[0][j], kd[1][j]); w.y = cvt_pk_bf16(kd[2][j], kd[3][j]);
            *(u32x2*)(KdT + (4 * cg + j) * 144 + rg * 8) = w;
            unsigned short e[4];
#pragma unroll
            for (int i = 0; i < 4; ++i) e[i] = (unsigned short)((j & 1) ? (vw[i][j >> 1] >> 16) : (vw[i][j >> 1] & 0xffff));
            u32x2 x; x.x = (unsigned)e[0] | ((unsigned)e[1] << 16); x.y = (unsigned)e[2] | ((unsigned)e[3] << 16);
            *(u32x2*)(Vt + (4 * cg + j) * 144 + rg * 8) = x;
        }
        if (rg == 0) *(f32x4*)(dc + (size_t)u * 128 + 4 * cg) = (f32x4){fexp(cb.bC[0]), fexp(cb.bC[1]), fexp(cb.bC[2]), fexp(cb.bC[3])};
        lds_barrier();
        bf16x8 bv[2]; u32x2 hold = {0u, 0u};
#pragma unroll
        for (int ks = 0; ks < 2; ++ks) bv[ks] = *(const bf16x8*)(Vt + (wid * 16 + fr) * 144 + ks * 64 + fq * 16);
#pragma unroll
        for (int kb = 0; kb < 8; ++kb) {
            f32x4 a = {0.f, 0.f, 0.f, 0.f};
#pragma unroll
            for (int ks = 0; ks < 2; ++ks) { const bf16x8 af = *(const bf16x8*)(KdT + ((fr >> 2) * 32 + kb * 4 + (fr & 3)) * 144 + ks * 64 + fq * 16); a = __builtin_amdgcn_mfma_f32_16x16x32_bf16(af, bv[ks], a, 0, 0, 0); }
            if (kb & 1) { u32x4 w; w.x = hold.x; w.y = hold.y; w.z = cvt_pk_bf16(a[0], a[1]); w.w = cvt_pk_bf16(a[2], a[3]);
                *(u32x4*)(dS + ((size_t)u * 128 + wid * 16 + fr) * 128 + fq * 32 + (kb - 1) * 4) = w; }
            else { hold.x = cvt_pk_bf16(a[0], a[1]); hold.y = cvt_pk_bf16(a[2], a[3]); }
        }
    }
}

__device__ __forceinline__ void phase_hscan(const Params& p, int L, int wid_s) {
    unsigned char* ws = p.ws; const int j = L >> 1;
    bf16_t* dS = (bf16_t*)(p.out + O_Y); const float* dc = (const float*)(ws + WS_DC);
    const int gtid = blockIdx.x * blockDim.x + tid_launder(wid_s), gsz = gridDim.x * blockDim.x;
    for (int task = gtid; task < 32 * 4096; task += gsz) {
        const int kq = task & 31, v = (task >> 5) & 127, bh = task >> 12, b = bh >> 3, h = bh & 7;
        f32x4 S = {0.f, 0.f, 0.f, 0.f};
        const size_t ustride = (size_t)8 * 16384; bf16_t* ptr = dS + ((size_t)(b * 128) * 8 + h) * 16384 + v * 128 + kq * 4;
        const float* dptr = dc + ((size_t)(b * 128) * 8 + h) * 128 + kq * 4;
        u32x2 w[8]; f32x4 d[8];
#pragma unroll
        for (int i = 0; i < 8; ++i) { w[i] = *(const u32x2*)(ptr + i * ustride); d[i] = *(const f32x4*)(dptr + (size_t)i * 8 * 128); }
        for (int c0 = 0; c0 < 128; c0 += 8) {
            u32x2 wn[8]; f32x4 dn[8];
            if (c0 + 8 < 128) {
#pragma unroll
                for (int i = 0; i < 8; ++i) { wn[i] = *(const u32x2*)(ptr + (size_t)(c0 + 8 + i) * ustride); dn[i] = *(const f32x4*)(dptr + (size_t)(c0 + 8 + i) * 8 * 128); }
            } else {
#pragma unroll
                for (int i = 0; i < 8; ++i) { wn[i] = (u32x2){0u, 0u}; dn[i] = (f32x4){0.f, 0.f, 0.f, 0.f}; }
            }
#pragma unroll
            for (int i = 0; i < 8; ++i) {
                u32x2 o; o.x = cvt_pk_bf16(S[0], S[1]); o.y = cvt_pk_bf16(S[2], S[3]);
#ifndef DIAG_NOSTORE
                *(u32x2*)(ptr + (size_t)(c0 + i) * ustride) = o;
#endif
                const f32x4 ds = {bf_lo(w[i].x), bf_hi(w[i].x), bf_lo(w[i].y), bf_hi(w[i].y)};
                S = d[i] * S + ds;
            }
#pragma unroll
            for (int i = 0; i < 8; ++i) { w[i] = wn[i]; d[i] = dn[i]; }
        }
        float* o = p.out + O_HGP + (((size_t)j * 4 + b) * 8 + h) * 16384 + (size_t)(kq * 4) * 128 + v;
        o[0] = S[0]; o[128] = S[1]; o[256] = S[2]; o[384] = S[3];
    }
#ifndef NO_SAMPLE_SCAN
    for (int task = gtid; task < 128 * 4096; task += gsz) {
        const int vq = task & 31, k = (task >> 5) & 127, bh = task >> 12, b = bh >> 3, h = bh & 7;
        const int u = (512 + b) * 8 + h;
        const size_t so = (((size_t)j * 16 + b) * 8 + h) * 16384 + (size_t)k * 128 + vq * 4;
        const f32x4 S0 = *(const f32x4*)(p.in[I_SHG] + so);
        const float dk = dc[(size_t)u * 128 + k];
        bf16_t* ptr = dS + (size_t)u * 16384 + (size_t)(vq * 4) * 128 + k;
        f32x4 Sf;
#pragma unroll
        for (int i = 0; i < 4; ++i) { const float ds = __uint_as_float((unsigned)ptr[i * 128] << 16); Sf[i] = dk * S0[i] + ds; ptr[i * 128] = (bf16_t)(cvt_pk_bf16(S0[i], 0.f) & 0xffff); }
        *(f32x4*)(p.out + O_HGS + so) = Sf;
    }
#endif
}

__device__ __forceinline__ void phase_hout(const Params& p, int L, int wid_s) {
    unsigned char* ws = p.ws; const int jj = L >> 1;
    float* T = (float*)smem;
    unsigned char* Q1 = smem + 8192;
    unsigned char* Q2 = Q1 + 64 * 272;
    unsigned char* K1 = Q2 + 64 * 272;
    unsigned char* Vt = K1 + 64 * 272;
    unsigned char* St = Vt + 128 * 144;
    unsigned char* Ab = St + 128 * 272;
    float* red = (float*)(Ab + 64 * 144);
    const _Float16* lf = (const _Float16*)(ws + WS_LF); const bf16_t* vb = (const bf16_t*)(ws + WS_VB); const bf16_t* gb = (const bf16_t*)(ws + WS_GB);
    bf16_t* qb = (bf16_t*)(ws + WS_QB); const bf16_t* Sc = (const bf16_t*)(p.out + O_Y);
    const float* gn = p.in[I_HNORMG] + jj * DM;
    const int tid = tid_launder(wid_s), cg = tid & 31, rg = tid >> 5, wid = tid >> 6, lane = tid & 63, fr = lane & 15, fq = lane >> 4;
    ChunkRaw nraw; u32x2 nq[4], nv[4]; u32x4 ns[4];
#define HOUT_LOAD(uu) do { const size_t org_ = (size_t)((uu) >> 3) * 64 * DM + ((uu) & 7) * 128; chunk_load_lf(lf + org_, nraw, tid); \
        _Pragma("unroll") for (int i = 0; i < 4; ++i) { const size_t o_ = org_ + (size_t)(4 * rg + i) * DM + 4 * cg; nq[i] = *(const u32x2*)(qb + o_); nv[i] = *(const u32x2*)(vb + o_); \
            const int idx_ = tid + 512 * i; ns[i] = *(const u32x4*)(Sc + (size_t)(uu) * 16384 + (idx_ >> 4) * 128 + (idx_ & 15) * 8); } } while (0)
    if ((int)blockIdx.x < 4224) HOUT_LOAD((int)blockIdx.x);
    for (int u = blockIdx.x; u < 4224; u += gridDim.x) {
        const int c = u >> 3, h = u & 7; const size_t org = (size_t)c * 64 * DM + h * 128;
        const ChunkRaw raw = nraw; u32x2 cq[4], cv[4]; u32x4 cs[4];
#pragma unroll
        for (int i = 0; i < 4; ++i) { cq[i] = nq[i]; cv[i] = nv[i]; cs[i] = ns[i]; }
        lds_barrier();
        ChunkB cb; chunk_cumsum(raw, cb, T, tid);
#pragma unroll
        for (int i = 0; i < 4; ++i) { const int idx = tid + 512 * i, r = idx >> 4, c8 = (idx & 15) * 8; *(u32x4*)(St + r * 272 + c8 * 2) = cs[i]; }
        unsigned vw[4][2];
#pragma unroll
        for (int i = 0; i < 4; ++i) {
            const u32x2 qw = cq[i]; const u32x2 w = cv[i]; vw[i][0] = w.x; vw[i][1] = w.y;
            const float q[4] = {bf_lo(qw.x), bf_hi(qw.x), bf_lo(qw.y), bf_hi(qw.y)};
            float q1[4], q2[4], k1[4];
#pragma unroll
            for (int j = 0; j < 4; ++j) { const float kk = 1.0f - fexp(cb.lf[i][j]); q1[j] = q[j] * fexp(cb.b[i][j] - cb.bref[j]); q2[j] = q[j] * fexp(cb.b[i][j]); k1[j] = kk * fexp(cb.bref[j] - cb.b[i][j]); }
            u32x2 a; a.x = cvt_pk_bf16(q1[0], q1[1]); a.y = cvt_pk_bf16(q1[2], q1[3]); *(u32x2*)(Q1 + (4 * rg + i) * 272 + cg * 8) = a;
            a.x = cvt_pk_bf16(q2[0], q2[1]); a.y = cvt_pk_bf16(q2[2], q2[3]); *(u32x2*)(Q2 + (4 * rg + i) * 272 + cg * 8) = a;
            a.x = cvt_pk_bf16(k1[0], k1[1]); a.y = cvt_pk_bf16(k1[2], k1[3]); *(u32x2*)(K1 + (4 * rg + i) * 272 + cg * 8) = a;
        }
#pragma unroll
        for (int j = 0; j < 4; ++j) {
            unsigned short e[4];
#pragma unroll
            for (int i = 0; i < 4; ++i) e[i] = (unsigned short)((j & 1) ? (vw[i][j >> 1] >> 16) : (vw[i][j >> 1] & 0xffff));
            u32x2 x; x.x = (unsigned)e[0] | ((unsigned)e[1] << 16); x.y = (unsigned)e[2] | ((unsigned)e[3] << 16);
            *(u32x2*)(Vt + (4 * cg + j) * 144 + rg * 8) = x;
        }
        lds_barrier();
        const int tb = wid & 3, hv = wid >> 2;
        const size_t orow = org + (size_t)(tb * 16 + fr) * DM;
        u32x4 gw8[2];
#pragma unroll
        for (int q = 0; q < 2; ++q) gw8[q] = *(const u32x4*)(gb + orow + hv * 64 + fq * 16 + q * 8);
        { const int un = u + (int)gridDim.x; if (un < 4224) HOUT_LOAD(un); }
#pragma unroll
        for (int q = 0; q < 2; ++q) {
            const int sb = hv * 2 + q; f32x4 a = {0.f, 0.f, 0.f, 0.f};
            if (sb <= tb) {
#pragma unroll
                for (int ks = 0; ks < 4; ++ks) { const bf16x8 af = *(const bf16x8*)(K1 + (sb * 16 + fr) * 272 + ks * 64 + fq * 16); const bf16x8 bf = *(const bf16x8*)(Q1 + (tb * 16 + fr) * 272 + ks * 64 + fq * 16);
                    a = __builtin_amdgcn_mfma_f32_16x16x32_bf16(af, bf, a, 0, 0, 0); }
#pragma unroll
                for (int r = 0; r < 4; ++r) if (sb * 16 + fq * 4 + r > tb * 16 + fr) a[r] = 0.f;
            }
            u32x2 w; w.x = cvt_pk_bf16(a[0], a[1]); w.y = cvt_pk_bf16(a[2], a[3]);
            *(u32x2*)(Ab + (tb * 16 + fr) * 144 + sb * 32 + fq * 8) = w;
        }
        f32x4 o4[4];
#pragma unroll
        for (int vi = 0; vi < 4; ++vi) o4[vi] = (f32x4){0.f, 0.f, 0.f, 0.f};
#pragma unroll
        for (int ks = 0; ks < 4; ++ks) { const bf16x8 bf = *(const bf16x8*)(Q2 + (tb * 16 + fr) * 272 + ks * 64 + fq * 16);
#pragma unroll
            for (int vi = 0; vi < 4; ++vi) { const bf16x8 af = *(const bf16x8*)(St + (hv * 64 + (fr >> 2) * 16 + vi * 4 + (fr & 3)) * 272 + ks * 64 + fq * 16); o4[vi] = __builtin_amdgcn_mfma_f32_16x16x32_bf16(af, bf, o4[vi], 0, 0, 0); } }
        lds_barrier();
#pragma unroll
        for (int ks = 0; ks < 2; ++ks) { const bf16x8 bf = *(const bf16x8*)(Ab + (tb * 16 + fr) * 144 + ks * 64 + fq * 16);
#pragma unroll
            for (int vi = 0; vi < 4; ++vi) { const bf16x8 af = *(const bf16x8*)(Vt + (hv * 64 + (fr >> 2) * 16 + vi * 4 + (fr & 3)) * 144 + ks * 64 + fq * 16); o4[vi] = __builtin_amdgcn_mfma_f32_16x16x32_bf16(af, bf, o4[vi], 0, 0, 0); } }
        float ss = 0.f;
#pragma unroll
        for (int vi = 0; vi < 4; ++vi) ss += (o4[vi][0] * o4[vi][0] + o4[vi][1] * o4[vi][1]) + (o4[vi][2] * o4[vi][2] + o4[vi][3] * o4[vi][3]);
        ss += __shfl_xor(ss, 16); ss += __shfl_xor(ss, 32);
        if (fq == 0) red[hv * 64 + tb * 16 + fr] = ss;
        lds_barrier();
        const float rs = rsqrtf((red[tb * 16 + fr] + red[64 + tb * 16 + fr]) * (1.0f / 128.0f) + EPS);
        u32x2 ow[4];
#pragma unroll
        for (int vi = 0; vi < 4; ++vi) {
            const int vc = hv * 64 + fq * 16 + vi * 4;
            const f32x4 g4 = *(const f32x4*)(gn + h * 128 + vc);
            const unsigned glo = (vi & 1) ? gw8[vi >> 1].z : gw8[vi >> 1].x, ghi = (vi & 1) ? gw8[vi >> 1].w : gw8[vi >> 1].y;
            const float r0 = o4[vi][0] * rs * g4[0] * bf_lo(glo), r1 = o4[vi][1] * rs * g4[1] * bf_hi(glo), r2 = o4[vi][2] * rs * g4[2] * bf_lo(ghi), r3 = o4[vi][3] * rs * g4[3] * bf_hi(ghi);
            ow[vi].x = cvt_pk_bf16(r0, r1); ow[vi].y = cvt_pk_bf16(r2, r3);
        }
#pragma unroll
        for (int q = 0; q < 2; ++q) { u32x4 w; w.x = ow[2 * q].x; w.y = ow[2 * q].y; w.z = ow[2 * q + 1].x; w.w = ow[2 * q + 1].y; *(u32x4*)(qb + orow + hv * 64 + fq * 16 + q * 8) = w; }
    }
}

__device__ __forceinline__ void phase_final(const Params& p, int wid_s) {
    const int tidf = tid_launder(wid_s); const int gtid = blockIdx.x * blockDim.x + tidf, gsz = gridDim.x * blockDim.x, wv = gtid >> 6, nwv = gsz >> 6, lane = tidf & 63;
    const float* ssq = (const float*)(p.ws + WS_SSQP) + (size_t)8 * SSQ_STRIDE; const float* g = p.in[I_NOUTG]; const bf16_t* xb = (const bf16_t*)(p.ws + WS_XB);
    for (int row = wv; row < M_TOK; row += 2 * nwv) {
        const int row2 = row + nwv; const bool has2 = row2 < M_TOK; const int r2 = has2 ? row2 : row;
        u32x4 a[2], b2[2];
#pragma unroll
        for (int i = 0; i < 2; ++i) { a[i] = *(const u32x4*)(xb + (size_t)row * DM + i * 512 + lane * 8); b2[i] = *(const u32x4*)(xb + (size_t)r2 * DM + i * 512 + lane * 8); }
        const float rs = rstd_row(ssq + (size_t)row * 16), rs2 = rstd_row(ssq + (size_t)r2 * 16);
#pragma unroll
        for (int i = 0; i < 2; ++i) {
            const int c = i * 512 + lane * 8; const f32x4 g0 = *(const f32x4*)(g + c), g1 = *(const f32x4*)(g + c + 4);
            float* y = p.out + O_Y + (size_t)row * DM + c;
            *(f32x4*)y = (f32x4){bf_lo(a[i].x), bf_hi(a[i].x), bf_lo(a[i].y), bf_hi(a[i].y)} * rs * g0; *(f32x4*)(y + 4) = (f32x4){bf_lo(a[i].z), bf_hi(a[i].z), bf_lo(a[i].w), bf_hi(a[i].w)} * rs * g1;
            if (has2) { float* y2 = p.out + O_Y + (size_t)row2 * DM + c;
                *(f32x4*)y2 = (f32x4){bf_lo(b2[i].x), bf_hi(b2[i].x), bf_lo(b2[i].y), bf_hi(b2[i].y)} * rs2 * g0; *(f32x4*)(y2 + 4) = (f32x4){bf_lo(b2[i].z), bf_hi(b2[i].z), bf_lo(b2[i].w), bf_hi(b2[i].w)} * rs2 * g1; }
        }
    }
}

constexpr size_t WS_BAR = 2 * MiB + 512 * 1024;
#define XB_CENSUS(j) (64 * (1 + (j)))
#define XB_SUB(j) (64 * (17 + (j)))
#define XB_XGEN(j) (64 * (33 + (j)))
#define XB_TOP (64 * 49)
#define XB_TOPGEN (64 * 50)
constexpr size_t XB_BYTES = 64 * 51 * 4;
__device__ __forceinline__ unsigned xb_ld(unsigned* p) { return __hip_atomic_load(p, __ATOMIC_RELAXED, __HIP_MEMORY_SCOPE_AGENT); }
__device__ __forceinline__ unsigned xb_add(unsigned* p, unsigned v) { return __hip_atomic_fetch_add(p, v, __ATOMIC_RELAXED, __HIP_MEMORY_SCOPE_AGENT); }
struct XBar { unsigned* bar; unsigned x, nloc, nx; };
__device__ __forceinline__ void grid_barrier(const XBar& b, int wid_s) {
    asm volatile("s_waitcnt vmcnt(0) lgkmcnt(0)" ::: "memory");
    __syncthreads();
    if (wid_s == 0) {
        if (tid_launder(wid_s) == 0) {
            const unsigned old = xb_add(&b.bar[XB_SUB(b.x)], 1u), gen = old / b.nloc;
            if (old + 1u == (gen + 1u) * b.nloc) {
                __builtin_amdgcn_fence(__ATOMIC_RELEASE, "agent");
                asm volatile("s_waitcnt vmcnt(0)" ::: "memory");
                const unsigned og = xb_add(&b.bar[XB_TOP], 1u), tg = og / b.nx;
                if (og + 1u == (tg + 1u) * b.nx) xb_add(&b.bar[XB_TOPGEN], 1u);
                else while (xb_ld(&b.bar[XB_TOPGEN]) == tg) __builtin_amdgcn_s_sleep(1);
                xb_add(&b.bar[XB_XGEN(b.x)], 1u);
            } else while (xb_ld(&b.bar[XB_XGEN(b.x)]) == gen) __builtin_amdgcn_s_sleep(1);
        }
        __builtin_amdgcn_fence(__ATOMIC_ACQUIRE, "agent");
        asm volatile("s_waitcnt vmcnt(0)" ::: "memory");
    }
    __syncthreads();
}

enum { OP_PREP = 0, OP_POOLD, OP_POOLG, OP_HIN, OP_HDS, OP_HSCAN, OP_HOUT, OP_HPROJ, OP_UP, OP_DOWN, OP_FINAL };
constexpr int NPH = 24;
__device__ __forceinline__ void phase_decode(int ph, int& op, int& L) {
    if (ph == 0) { op = OP_PREP; L = 0; return; }
    if (ph == 23) { op = OP_FINAL; L = 0; return; }
    int q = ph - 1;
    const int pr = q / 11; q %= 11;
    if (q < 4) { L = 2 * pr; op = q == 0 ? OP_POOLD : q == 1 ? OP_POOLG : q == 2 ? OP_UP : OP_DOWN; }
    else { q -= 4; L = 2 * pr + 1; op = q == 0 ? OP_HIN : q == 1 ? OP_HDS : q == 2 ? OP_HSCAN : q == 3 ? OP_HOUT : q == 4 ? OP_HPROJ : q == 5 ? OP_UP : OP_DOWN; }
}

template <int MASK>
__device__ __forceinline__ void run_op(const Params& p, int op, int L, int wid_s, unsigned long long* tk = nullptr, bool coop = false) {
    unsigned char* ws = p.ws;
    float* xf = p.out + O_Y; bf16_t* xb = (bf16_t*)(ws + WS_XB); float* ssq = (float*)(ws + WS_SSQP);
#define PHON(x) if (!((MASK >> (x)) & 1)) break;
    switch (op) {
    case OP_PREP: PHON(OP_PREP) phase_prep(p, wid_s); break;
    case OP_POOLD: PHON(OP_POOLD) phase_pool_d(p, L, wid_s); break;
    case OP_HDS: PHON(OP_HDS) phase_hds(p, wid_s); break;
    case OP_HSCAN: PHON(OP_HSCAN) phase_hscan(p, L, wid_s); break;
    case OP_HOUT: PHON(OP_HOUT) phase_hout(p, L, wid_s); break;
    case OP_FINAL: PHON(OP_FINAL) phase_final(p, wid_s); break;
    case OP_POOLG: case OP_HPROJ: case OP_DOWN: { PHON(OP_DOWN)
        GemmArgs g; EpiResid e; e.xf = xf; e.xb = xb; e.xin_p = nullptr; e.xin_s = nullptr; e.colscale = nullptr; e.koff_per_pn = 0; e.flags = nullptr;
        g.nM = M_TOK / BM; g.nN = DM / BM;
        if (op == OP_POOLG) { g.A = (const bf16_t*)(ws + WS_DBUF); g.lda = DM; g.K = 256; g.Bt = (const bf16_t*)(ws + WS_WPOOL) + (size_t)(L >> 1) * 4 * 65536; g.ldb = 256;
            e.colscale = p.in[I_POOLSC] + (L >> 1) * DM; e.koff_per_pn = 256; e.ssq = ssq + (size_t)(2 * L + 1) * SSQ_STRIDE;
            if (L == 0) { e.xin_p = p.in[I_XP]; e.xin_s = p.in[I_XS]; } }
        else if (op == OP_HPROJ) { g.A = (const bf16_t*)(ws + WS_QB); g.lda = DM; g.K = DM; g.Bt = (const bf16_t*)(ws + WS_WOUT) + (size_t)(L >> 1) * DM * DM; g.ldb = DM; e.ssq = ssq + (size_t)(2 * L + 1) * SSQ_STRIDE; }
        else { g.A = (const bf16_t*)(ws + WS_HID); g.lda = FF; g.K = FF; g.Bt = (const bf16_t*)(ws + WS_WDN) + (size_t)L * DM * FF; g.ldb = FF; e.ssq = ssq + (size_t)(2 * L + 2) * SSQ_STRIDE;
            if (coop && gridDim.x == 256) e.flags = (unsigned*)(ws + WS_BAR + XB_BYTES) + L * 16; }
        gemm_phase(g, e, wid_s, tk);
        if (op == OP_DOWN && L < 3) {
            const int nwg3 = e.flags ? 32 : 528 - 2 * (int)gridDim.x;
            if (nwg3 > 0 && (int)blockIdx.x >= nwg3) prep_weights_layer(p, L + 1, (int)blockIdx.x - nwg3, (int)gridDim.x - nwg3, wid_s);
            else if (nwg3 <= 0) prep_weights_layer(p, L + 1, (int)blockIdx.x, (int)gridDim.x, wid_s);
        }
    } break;
    case OP_HIN: { PHON(OP_HIN)
        GemmArgs g; g.A = xb; g.lda = DM; g.K = DM; g.Bt = (const bf16_t*)(ws + WS_WIN) + (size_t)(L >> 1) * 4 * DM * DM; g.ldb = DM; g.nM = M_TOK / BM; g.nN = 4 * DM / BM;
        EpiHin e; e.last_pm = -1; e.ssq = ssq + (size_t)(2 * L) * SSQ_STRIDE; e.lb = (const float*)(ws + WS_LB) + L * DM; e.ws = ws;
        gemm_phase(g, e, wid_s, tk);
    } break;
    case OP_UP: { PHON(OP_UP)
        GemmArgs g; g.A = xb; g.lda = DM; g.K = DM; g.Bt = (const bf16_t*)(ws + WS_WUP) + (size_t)L * 2 * FF * DM; g.ldb = DM; g.nM = 136; g.nN = 2 * FF / BM;
        EpiUp e; e.last_pm = -1; e.ssq = ssq + (size_t)(2 * L + 1) * SSQ_STRIDE; e.cw = p.in[I_CONVW] + (size_t)L * 3 * FF; e.cb = p.in[I_CONVB] + (size_t)L * FF; e.hist = p.in[I_SCONV] + (size_t)L * 16 * 2 * FF;
        e.hid = (bf16_t*)(ws + WS_HID); e.cvp = p.out + O_CVP + (size_t)L * 4 * 2 * FF; e.cvs = p.out + O_CVS + (size_t)L * 16 * 2 * FF;
        gemm_phase(g, e, wid_s, tk);
    } break;
    }
#undef PHON
}

__global__ void __launch_bounds__(512, 2) mega(Params p, int ph_lo, int ph_hi) {
    const int wid_s = __builtin_amdgcn_readfirstlane((int)(threadIdx.x >> 6));
    XBar xb; xb.bar = (unsigned*)(p.ws + WS_BAR); xb.x = (unsigned)__builtin_amdgcn_s_getreg((3 << 11) | 20) & 0xFu; xb.nloc = 1u; xb.nx = 1u;
    if (threadIdx.x == 0) (void)xb_add(&xb.bar[XB_CENSUS(xb.x)], 1u);
#ifdef REPORT_MASK
    unsigned long long t_acc = 0;
#endif
    for (int ph = ph_lo; ph < ph_hi; ++ph) {
        int op, L; phase_decode(ph, op, L);
#ifdef REPORT_MASK
        const unsigned long long t_ph0 = __builtin_amdgcn_s_memrealtime();
#endif
        switch (op) {
        case OP_PREP: run_op<1 << OP_PREP>(p, OP_PREP, L, wid_s); break;
        case OP_POOLD: run_op<1 << OP_POOLD>(p, OP_POOLD, L, wid_s); break;
        case OP_POOLG: run_op<1 << OP_DOWN>(p, OP_POOLG, L, wid_s); break;
        case OP_HIN: run_op<1 << OP_HIN>(p, OP_HIN, L, wid_s); break;
        case OP_HDS: run_op<1 << OP_HDS>(p, OP_HDS, L, wid_s); break;
        case OP_HSCAN: run_op<1 << OP_HSCAN>(p, OP_HSCAN, L, wid_s); break;
        case OP_HOUT: run_op<1 << OP_HOUT>(p, OP_HOUT, L, wid_s); break;
        case OP_HPROJ: run_op<1 << OP_DOWN>(p, OP_HPROJ, L, wid_s); break;
#if defined(REPORT_KLOOP) && REPORT_KLOOP == 8
        case OP_UP: run_op<1 << OP_UP>(p, OP_UP, L, wid_s, &t_acc); break;
#else
        case OP_UP: run_op<1 << OP_UP>(p, OP_UP, L, wid_s); break;
#endif
#if defined(REPORT_KLOOP) && REPORT_KLOOP == 9
        case OP_DOWN: run_op<1 << OP_DOWN>(p, OP_DOWN, L, wid_s, &t_acc); break;
#else
        case OP_DOWN: run_op<1 << OP_DOWN>(p, OP_DOWN, L, wid_s, nullptr, true); break;
#endif
        default: run_op<1 << OP_FINAL>(p, OP_FINAL, L, wid_s); break;
        }
        if (ph + 1 < ph_hi) {
            if (ph == ph_lo) {
                cg::this_grid().sync();
                unsigned mine = 0u, cnt = 0u;
#pragma unroll
                for (unsigned j = 0; j < 16; ++j) { const unsigned c = xb_ld(&xb.bar[XB_CENSUS(j)]); cnt += c > 0u ? 1u : 0u; mine = j == xb.x ? c : mine; }
                xb.nloc = (unsigned)__builtin_amdgcn_readfirstlane((int)(mine > 0u ? mine : 1u)); xb.nx = (unsigned)__builtin_amdgcn_readfirstlane((int)(cnt > 0u ? cnt : 1u));
            } else grid_barrier(xb, wid_s);
        }
#ifdef REPORT_MASK
        if ((REPORT_MASK >> op) & 1) t_acc += __builtin_amdgcn_s_memrealtime() - t_ph0;
#endif
    }
#ifdef REPORT_MASK
    { const unsigned long long t_e = __builtin_amdgcn_s_memrealtime(); while (__builtin_amdgcn_s_memrealtime() - t_e < t_acc) __builtin_amdgcn_s_sleep(16); }
#endif
}
template <int OP>
__global__ void __launch_bounds__(512, 2) phase_kernel(Params p, int L) {
    const int wid_s = __builtin_amdgcn_readfirstlane((int)(threadIdx.x >> 6));
    constexpr int MASK = (OP == OP_POOLG || OP == OP_HPROJ) ? (1 << OP_DOWN) : (1 << OP);
    run_op<MASK>(p, OP, L, wid_s);
}
template <int OP> static void launch_phase(const Params& p, int L, int grid, hipStream_t stream) {
    static bool attr = false;
    if (!attr) { (void)hipFuncSetAttribute((const void*)phase_kernel<OP>, hipFuncAttributeMaxDynamicSharedMemorySize, LDS_BYTES); attr = true; }
    hipLaunchKernelGGL(phase_kernel<OP>, dim3(grid), dim3(512), LDS_BYTES, stream, p, L);
}

extern "C" void kernel_launch(void* const* d_in, const int* in_sizes, int n_in, void* d_out, int out_size, void* d_ws, size_t ws_size, hipStream_t stream) {
    static int grid_blocks = 0;
    if (!grid_blocks) {
        hipFuncSetAttribute((const void*)mega, hipFuncAttributeMaxDynamicSharedMemorySize, LDS_BYTES);
        int dev = 0, cus = 0, per_cu = 0; hipGetDevice(&dev);
        hipDeviceGetAttribute(&cus, hipDeviceAttributeMultiprocessorCount, dev);
        hipOccupancyMaxActiveBlocksPerMultiprocessor(&per_cu, mega, 512, LDS_BYTES);
        if (per_cu < 1) per_cu = 1;
        grid_blocks = cus * 1;
        if (ws_size < WS_NEED) fprintf(stderr, "workspace too small: %zu < %zu\n", ws_size, (size_t)WS_NEED);
    }
    if (ws_size < WS_NEED || n_in != 18) return;
    Params p{};
    for (int i = 0; i < 18; ++i) p.in[i] = (const float*)d_in[i];
    p.out = (float*)d_out; p.ws = (unsigned char*)d_ws;
#if defined(BISECT_N)
    for (int ph = 0; ph < BISECT_N; ++ph) hipLaunchKernelGGL(mega, dim3(grid_blocks), dim3(512), LDS_BYTES, stream, p, ph, ph + 1);
#elif MK_SINGLE
    (void)hipMemsetAsync((unsigned char*)d_ws + WS_BAR, 0, XB_BYTES + 256, stream);
    int lo = 0, hi = NPH; void* args[] = {&p, &lo, &hi};
    hipError_t e = hipLaunchCooperativeKernel((const void*)mega, dim3(grid_blocks), dim3(512), args, LDS_BYTES, stream);
    if (e != hipSuccess) fprintf(stderr, "cooperative launch failed: %s (grid %d)\n", hipGetErrorString(e), grid_blocks);
#else
    for (int ph = 0; ph < NPH; ++ph) {
        int op, L;
        if (ph == 0) { op = OP_PREP; L = 0; } else if (ph == 23) { op = OP_FINAL; L = 0; }
        else { int q = ph - 1; const int pr = q / 11; q %= 11;
            if (q < 4) { L = 2 * pr; op = q == 0 ? OP_POOLD : q == 1 ? OP_POOLG : q == 2 ? OP_UP : OP_DOWN; }
            else { q -= 4; L = 2 * pr + 1; op = q == 0 ? OP_HIN : q == 1 ? OP_HDS : q == 2 ? OP_HSCAN : q == 3 ? OP_HOUT : q == 4 ? OP_HPROJ : q == 5 ? OP_UP : OP_DOWN; } }
        switch (op) {
        case OP_PREP: launch_phase<OP_PREP>(p, L, grid_blocks, stream); break;
        case OP_POOLD: launch_phase<OP_POOLD>(p, L, grid_blocks, stream); break;
        case OP_POOLG: launch_phase<OP_POOLG>(p, L, grid_blocks, stream); break;
        case OP_HIN: launch_phase<OP_HIN>(p, L, grid_blocks, stream); break;
        case OP_HDS: launch_phase<OP_HDS>(p, L, grid_blocks, stream); break;
        case OP_HSCAN: launch_phase<OP_HSCAN>(p, L, grid_blocks, stream); break;
        case OP_HOUT: launch_phase<OP_HOUT>(p, L, grid_blocks, stream); break;
        case OP_HPROJ: launch_phase<OP_HPROJ>(p, L, grid_blocks, stream); break;
        case OP_UP: launch_phase<OP_UP>(p, L, grid_blocks, stream); break;
        case OP_DOWN: launch_phase<OP_DOWN>(p, L, grid_blocks, stream); break;
        default: launch_phase<OP_FINAL>(p, L, grid_blocks, stream); break;
        }
    }
#endif
}
```
